# Optimizing an MI355X kernel written in HIP

```python
import jax, jax.numpy as jnp
from jax import lax
import numpy as np

D_MODEL = 1024
BATCH = 8
SEQ = 4096
DEPTH = 4

N_EVEN = (DEPTH + 1) // 2
N_ODD = DEPTH // 2
ROPE_THETA = 10000.0
EPS = 1e-6
NEG = -1e30
Q_BLOCK = 128

A_HEADS = 8
A_NOPE = 64
A_ROPE = 32
A_VD = 64
A_QLAT = 256
A_KVLAT = 128
A_WIDTH = A_HEADS * A_VD

B_HEADS = 8
B_KV_HEADS = 2
B_HD = 64
B_WIDTH = B_HEADS * B_HD
B_KV = B_KV_HEADS * B_HD
CMP_LEN = 32
CMP_STRIDE = 16
SEL_LEN = 64
N_SEL = 16
WINDOW = 512
NSA_Q_BLOCK = 64

C_HEADS = 8
C_HD = 64
C_WIDTH = C_HEADS * C_HD
IDX_HEADS = 8
IDX_HD = 32
TOPK_MAX = 256

D_HEADS = 4
D_QK = 64
D_VD = 128
D_QK_W = D_HEADS * D_QK
D_WIDTH = D_HEADS * D_VD
CONV_W = 4
CHUNK = 64

M_SLOTS = 256
M_HEADS = 4
M_HD = 64
M_WIDTH = M_HEADS * M_HD

MIX_WIDTH = A_WIDTH + B_WIDTH + M_WIDTH

EVEN_SIZES = (A_QLAT, A_KVLAT, A_ROPE, A_WIDTH,
              B_WIDTH, B_KV, B_KV, B_KV, B_KV, B_KV, B_KV, 3 * B_HEADS, B_WIDTH,
              M_WIDTH, M_WIDTH)
EVEN_COLS = A_QLAT + A_KVLAT + A_ROPE + A_WIDTH + 2 * B_WIDTH + 6 * B_KV + 3 * B_HEADS + 2 * M_WIDTH
ODD_SIZES = (C_WIDTH, C_HD, C_HD, IDX_HEADS * IDX_HD, IDX_HD, IDX_HEADS, C_WIDTH,
             D_QK_W, D_QK_W, D_WIDTH, D_HEADS, D_HEADS, D_WIDTH, D_WIDTH,
             M_WIDTH, M_WIDTH)
ODD_COLS = 2 * C_WIDTH + 2 * C_HD + IDX_HEADS * IDX_HD + IDX_HD + IDX_HEADS + 2 * D_QK_W + 3 * D_WIDTH + 2 * D_HEADS + 2 * M_WIDTH

kernel_name = "hybrid_mla_nsa_dsa_mlstm_trunk"


def rms_norm(x, g):
    xf = x.astype(jnp.float32)
    y = xf * lax.rsqrt(jnp.mean(xf * xf, axis=-1, keepdims=True) + EPS)
    return (y * g.astype(jnp.float32)).astype(x.dtype)


def rope(x, pos):
    d2 = x.shape[-1] // 2
    inv = ROPE_THETA ** (-jnp.arange(d2, dtype=jnp.float32) / d2)
    ang = pos.astype(jnp.float32)[..., None, None] * inv
    c, s = jnp.cos(ang), jnp.sin(ang)
    xf = x.astype(jnp.float32)
    x1, x2 = xf[..., :d2], xf[..., d2:]
    return jnp.concatenate([x1 * c - x2 * s, x1 * s + x2 * c], axis=-1).astype(x.dtype)


def split_cols(u, sizes):
    out, start = [], 0
    for n in sizes:
        out.append(u[..., start:start + n])
        start += n
    return out


def to_blocks(t, qb):
    return t.reshape(t.shape[0], t.shape[1] // qb, qb, *t.shape[2:]).swapaxes(0, 1)


def from_blocks(o):
    o = o.swapaxes(0, 1)
    return o.reshape(o.shape[0], o.shape[1] * o.shape[2], -1)


def causal_attention_blocked(q, k, v, scale):
    S = q.shape[1]
    kpos = jnp.arange(S)

    def block(args):
        qi, qx = args
        t = qi * Q_BLOCK + jnp.arange(Q_BLOCK)
        s = jnp.einsum('bqhd,bkhd->bhqk', qx, k).astype(jnp.float32) * scale
        s = jnp.where(kpos[None, :] <= t[:, None], s, NEG)
        p = jax.nn.softmax(s, axis=-1).astype(v.dtype)
        return jnp.einsum('bhqk,bkhd->bqhd', p, v)

    o = lax.map(block, (jnp.arange(S // Q_BLOCK), to_blocks(q, Q_BLOCK)))
    return from_blocks(o)


def mla_mixer(q_lat, kv_lat, k_rope, pos, q_lat_g, kv_lat_g, w_uq, w_ukv, q_norm_g, k_norm_g):
    B, S, _ = q_lat.shape
    q = (rms_norm(q_lat, q_lat_g) @ w_uq).reshape(B, S, A_HEADS, A_NOPE + A_ROPE)
    kv = (rms_norm(kv_lat, kv_lat_g) @ w_ukv).reshape(B, S, A_HEADS, A_NOPE + A_VD)
    q_nope = rms_norm(q[..., :A_NOPE], q_norm_g[:A_NOPE])
    q_pe = rope(rms_norm(q[..., A_NOPE:], q_norm_g[A_NOPE:]), pos)
    k_nope = rms_norm(kv[..., :A_NOPE], k_norm_g[:A_NOPE])
    k_pe = rope(rms_norm(k_rope[:, :, None, :], k_norm_g[A_NOPE:]), pos)
    k_pe = jnp.broadcast_to(k_pe, (B, S, A_HEADS, A_ROPE))
    qf = jnp.concatenate([q_nope, q_pe], axis=-1)
    kf = jnp.concatenate([k_nope, k_pe], axis=-1)
    v = kv[..., A_NOPE:]
    o = causal_attention_blocked(qf, kf, v, (A_NOPE + A_ROPE) ** -0.5)
    return o.reshape(B, S, A_WIDTH)


def nsa_mixer(q, k_c, v_c, k_s, v_s, k_w, v_w, gates, pos, q_g, k_g, cmp_pos, cmp_w1, cmp_w2):
    B, S, _ = q.shape
    G, R, hd = B_KV_HEADS, B_HEADS // B_KV_HEADS, B_HD
    scale = hd ** -0.5
    q = rope(rms_norm(q.reshape(B, S, B_HEADS, hd), q_g), pos)
    k_c, v_c, k_s, v_s, k_w, v_w = [t.reshape(B, S, G, hd) for t in (k_c, v_c, k_s, v_s, k_w, v_w)]
    k_s = rope(rms_norm(k_s, k_g[1]), pos)
    k_w = rope(rms_norm(k_w, k_g[2]), pos)

    n_cmp = (S - CMP_LEN) // CMP_STRIDE + 1
    tok = jnp.arange(n_cmp)[:, None] * CMP_STRIDE + jnp.arange(CMP_LEN)[None, :]
    cmp_end = tok[:, -1]

    def compress(t, pe, w1, w2):
        blk = t[:, tok] + pe[:, None, :]
        flat = blk.transpose(0, 1, 3, 2, 4).reshape(B, n_cmp, G, CMP_LEN * hd)
        return jax.nn.silu(flat @ w1) @ w2

    kcmp = rope(rms_norm(compress(k_c, cmp_pos[0], cmp_w1[0], cmp_w2[0]), k_g[0]), pos[:, cmp_end])
    vcmp = compress(v_c, cmp_pos[1], cmp_w1[1], cmp_w2[1])

    n_blk = S // SEL_LEN
    n_sel = min(N_SEL, n_blk)
    blk_start = jnp.arange(n_blk) * SEL_LEN
    overlap = ((tok[:, :1] <= blk_start[None, :] + SEL_LEN - 1)
               & (cmp_end[:, None] >= blk_start[None, :])).astype(jnp.float32)
    ksb = k_s.reshape(B, n_blk, SEL_LEN, G, hd).transpose(0, 3, 1, 2, 4)
    vsb = v_s.reshape(B, n_blk, SEL_LEN, G, hd).transpose(0, 3, 1, 2, 4)
    bi = jnp.arange(B)[:, None, None, None]
    gi = jnp.arange(G)[None, :, None, None]
    jb = jnp.arange(n_blk)

    kwp = jnp.pad(k_w, ((0, 0), (WINDOW, 0), (0, 0), (0, 0)))
    vwp = jnp.pad(v_w, ((0, 0), (WINDOW, 0), (0, 0), (0, 0)))

    qb = to_blocks(q.reshape(B, S, G, R, hd), NSA_Q_BLOCK)
    gb = to_blocks(jax.nn.sigmoid(gates.astype(jnp.float32)).reshape(B, S, G, R, 3), NSA_Q_BLOCK)

    def block(args):
        qi, qx, gx = args
        t = qi * NSA_Q_BLOCK + jnp.arange(NSA_Q_BLOCK)
        s = jnp.einsum('bqgrd,bngd->bgrqn', qx, kcmp).astype(jnp.float32) * scale
        m_c = cmp_end[None, :] <= t[:, None]
        p_c = jax.nn.softmax(jnp.where(m_c, s, NEG), axis=-1) * m_c
        o_c = jnp.einsum('bgrqn,bngd->bqgrd', p_c.astype(vcmp.dtype), vcmp)
        imp = jnp.einsum('bgrqn,nj->bgqj', p_c, overlap)
        cur = (t // SEL_LEN)[:, None]
        forced = jnp.where(jb[None, :] == cur, 3e4,
                           jnp.where(jb[None, :] == cur - 1, 2e4,
                                     jnp.where(jb[None, :] == 0, 1e4, 0.0)))
        adm = blk_start[None, :] <= t[:, None]
        score = jnp.where(adm, imp + forced, NEG)
        _, sel = lax.top_k(score, n_sel)
        kg = ksb[bi, gi, sel]
        vg = vsb[bi, gi, sel]
        s = jnp.einsum('bqgrd,bgqnld->bgrqnl', qx, kg).astype(jnp.float32) * scale
        kpos = sel[..., None] * SEL_LEN + jnp.arange(SEL_LEN)
        m_s = kpos <= t[None, None, :, None, None]
        s = jnp.where(m_s[:, :, None], s, NEG)
        p_s = jax.nn.softmax(s.reshape(*s.shape[:4], -1), axis=-1).reshape(s.shape)
        o_s = jnp.einsum('bgrqnl,bgqnld->bqgrd', p_s.astype(vg.dtype), vg)
        kx = lax.dynamic_slice_in_dim(kwp, qi * NSA_Q_BLOCK, WINDOW + NSA_Q_BLOCK, axis=1)
        vx = lax.dynamic_slice_in_dim(vwp, qi * NSA_Q_BLOCK, WINDOW + NSA_Q_BLOCK, axis=1)
        kp = qi * NSA_Q_BLOCK - WINDOW + jnp.arange(WINDOW + NSA_Q_BLOCK)
        m_w = (kp[None, :] <= t[:, None]) & (kp[None, :] > t[:, None] - WINDOW) & (kp[None, :] >= 0)
        s = jnp.einsum('bqgrd,bkgd->bgrqk', qx, kx).astype(jnp.float32) * scale
        p_w = jax.nn.softmax(jnp.where(m_w, s, NEG), axis=-1)
        o_w = jnp.einsum('bgrqk,bkgd->bqgrd', p_w.astype(vx.dtype), vx)
        o = gx[..., 0:1] * o_c + gx[..., 1:2] * o_s + gx[..., 2:3] * o_w
        return o.astype(qx.dtype)

    o = lax.map(block, (jnp.arange(S // NSA_Q_BLOCK), qb, gb))
    return from_blocks(o)


def dsa_mixer(q, k, v, iq, ik, iw, pos, q_g, k_g):
    B, S, _ = q.shape
    topk = min(TOPK_MAX, S // 4)
    scale = C_HD ** -0.5
    q = rope(rms_norm(q.reshape(B, S, C_HEADS, C_HD), q_g), pos)
    k = rope(rms_norm(k.reshape(B, S, 1, C_HD), k_g), pos)[:, :, 0]
    iq = rope(iq.reshape(B, S, IDX_HEADS, IDX_HD), pos)
    ik = rope(ik.reshape(B, S, 1, IDX_HD), pos)[:, :, 0]
    iw = iw * IDX_HEADS ** -0.5
    kpos = jnp.arange(S)
    bi = jnp.arange(B)[:, None, None]

    def block(args):
        qi, qx, iqx, iwx = args
        t = qi * Q_BLOCK + jnp.arange(Q_BLOCK)
        logits = jax.nn.relu(jnp.einsum('bqhd,bsd->bqhs', iqx, ik).astype(jnp.float32))
        score = jnp.einsum('bqh,bqhs->bqs', iwx.astype(jnp.float32), logits)
        score = jnp.where(kpos[None, None, :] <= t[None, :, None], score, NEG)
        _, sel = lax.top_k(score, topk)
        kg = k[bi, sel]
        vg = v[bi, sel]
        s = jnp.einsum('bqhd,bqkd->bhqk', qx, kg).astype(jnp.float32) * scale
        s = jnp.where((sel <= t[None, :, None])[:, None], s, NEG)
        p = jax.nn.softmax(s, axis=-1).astype(vg.dtype)
        return jnp.einsum('bhqk,bqkd->bqhd', p, vg)

    o = lax.map(block, (jnp.arange(S // Q_BLOCK), to_blocks(q, Q_BLOCK), to_blocks(iq, Q_BLOCK), to_blocks(iw, Q_BLOCK)))
    return from_blocks(o)


def mlstm_mixer(q, k, v, i_pre, f_pre, o_pre, conv_w, conv_b, i_bias, f_bias, h_norm_g):
    B, S, _ = q.shape
    dt = q.dtype
    H, dk, dv = D_HEADS, D_QK, D_VD
    qk = jnp.concatenate([q, k], axis=-1)
    y = lax.conv_general_dilated(qk, conv_w[:, None, :], window_strides=(1,), padding=[(CONV_W - 1, 0)],
                                 dimension_numbers=('NWC', 'WIO', 'NWC'), feature_group_count=qk.shape[-1])
    qk = jax.nn.silu(y + conv_b)
    f32 = jnp.float32
    qh = qk[..., :D_QK_W].reshape(B, S, H, dk).astype(f32)
    kh = qk[..., D_QK_W:].reshape(B, S, H, dk).astype(f32) * dk ** -0.5
    vh = v.reshape(B, S, H, dv).astype(f32)
    ig = (i_pre + i_bias).astype(f32)
    lf = jax.nn.log_sigmoid((f_pre + f_bias).astype(f32))
    nc = S // CHUNK

    def chunks(t):
        t = t.reshape(B, nc, CHUNK, H, *t.shape[3:])
        return jnp.moveaxis(jnp.moveaxis(t, 1, 0), 3, 2)

    tril = jnp.tri(CHUNK, dtype=bool)

    def step(carry, inp):
        C, n, m = carry
        qc, kc, vc, ic, lfc = inp
        b = jnp.cumsum(lfc, axis=-1)
        D = jnp.where(tril, b[..., :, None] - b[..., None, :] + ic[..., None, :], NEG)
        inter = b + m[..., None]
        m_t = jnp.maximum(inter, D.max(-1))
        a = jnp.exp(inter - m_t)
        w = jnp.einsum('bhtd,bhsd->bhts', qc, kc) * jnp.exp(D - m_t[..., None])
        num = a[..., None] * jnp.einsum('bhtd,bhdv->bhtv', qc, C) + jnp.einsum('bhts,bhsv->bhtv', w, vc)
        den = a * jnp.einsum('bhtd,bhd->bht', qc, n) + w.sum(-1)
        h = num / jnp.maximum(jnp.abs(den), jnp.exp(-m_t))[..., None]
        bL = b[..., -1]
        g = bL[..., None] - b + ic
        m_new = jnp.maximum(bL + m, g.max(-1))
        ws = jnp.exp(g - m_new[..., None])
        decay = jnp.exp(bL + m - m_new)
        C_new = decay[..., None, None] * C + jnp.einsum('bhs,bhsd,bhsv->bhdv', ws, kc, vc)
        n_new = decay[..., None] * n + jnp.einsum('bhs,bhsd->bhd', ws, kc)
        return (C_new, n_new, m_new), h

    init = (jnp.zeros((B, H, dk, dv), f32), jnp.zeros((B, H, dk), f32), jnp.zeros((B, H), f32))
    _, hs = lax.scan(step, init, (chunks(qh), chunks(kh), chunks(vh), chunks(ig), chunks(lf)))
    h = jnp.moveaxis(jnp.moveaxis(hs, 3, 2), 0, 1).reshape(B, S, H, dv)
    h = rms_norm(h, h_norm_g).reshape(B, S, D_WIDTH)
    return (jax.nn.sigmoid(o_pre.astype(f32)) * h).astype(dt)


def mem_xattn(q_raw, mem, mem_norm_g, w_kv, q_g, k_g):
    B, S, _ = q_raw.shape
    q = rms_norm(q_raw.reshape(B, S, M_HEADS, M_HD), q_g)
    kv = (rms_norm(mem, mem_norm_g) @ w_kv).reshape(B, mem.shape[1], 2, M_HEADS, M_HD)
    k = rms_norm(kv[:, :, 0], k_g)
    v = kv[:, :, 1]
    s = jnp.einsum('bqhd,bmhd->bhqm', q, k).astype(jnp.float32) * M_HD ** -0.5
    p = jax.nn.softmax(s, axis=-1).astype(v.dtype)
    return jnp.einsum('bhqm,bmhd->bqhd', p, v).reshape(B, S, M_WIDTH)


def setup_inputs(seed: int = 0) -> dict:
    key = jax.random.key(seed)
    keys = iter(jax.random.split(key, 40))
    f32 = jnp.float32

    def nrm(shape, scale):
        return jax.random.normal(next(keys), shape, f32) * scale

    def gain(shape):
        return 1.0 + 0.02 * jax.random.normal(next(keys), shape, f32)

    x = nrm((BATCH, SEQ, D_MODEL), 1.0)
    mem = nrm((BATCH, M_SLOTS, D_MODEL), 1.0)
    start = jax.random.randint(next(keys), (BATCH, 1), 0, 4096, dtype=jnp.int32)
    positions = start + jnp.arange(SEQ, dtype=jnp.int32)[None, :]
    return {
        "x": x,
        "mem": mem,
        "positions": positions,
        "ln_g": gain((DEPTH, D_MODEL)),
        "mem_norm_g": gain((DEPTH, D_MODEL)),
        "mem_w_kv": nrm((DEPTH, D_MODEL, 2 * M_WIDTH), D_MODEL ** -0.5),
        "mem_q_norm_g": gain((DEPTH, M_HD)),
        "mem_k_norm_g": gain((DEPTH, M_HD)),
        "w_out": nrm((DEPTH, MIX_WIDTH, D_MODEL), MIX_WIDTH ** -0.5),
        "even_w_in": nrm((N_EVEN, D_MODEL, EVEN_COLS), D_MODEL ** -0.5),
        "mla_q_lat_g": gain((N_EVEN, A_QLAT)),
        "mla_kv_lat_g": gain((N_EVEN, A_KVLAT)),
        "mla_w_uq": nrm((N_EVEN, A_QLAT, A_HEADS * (A_NOPE + A_ROPE)), A_QLAT ** -0.5),
        "mla_w_ukv": nrm((N_EVEN, A_KVLAT, A_HEADS * (A_NOPE + A_VD)), A_KVLAT ** -0.5),
        "mla_q_norm_g": gain((N_EVEN, A_NOPE + A_ROPE)),
        "mla_k_norm_g": gain((N_EVEN, A_NOPE + A_ROPE)),
        "nsa_q_norm_g": gain((N_EVEN, B_HD)),
        "nsa_k_norm_g": gain((N_EVEN, 3, B_HD)),
        "nsa_cmp_pos": nrm((N_EVEN, 2, CMP_LEN, B_HD), 0.02),
        "nsa_cmp_w1": nrm((N_EVEN, 2, CMP_LEN * B_HD, B_HD), (CMP_LEN * B_HD) ** -0.5),
        "nsa_cmp_w2": nrm((N_EVEN, 2, B_HD, B_HD), B_HD ** -0.5),
        "odd_w_in": nrm((N_ODD, D_MODEL, ODD_COLS), D_MODEL ** -0.5),
        "dsa_q_norm_g": gain((N_ODD, C_HD)),
        "dsa_k_norm_g": gain((N_ODD, C_HD)),
        "mlstm_conv_w": nrm((N_ODD, CONV_W, 2 * D_QK_W), CONV_W ** -0.5),
        "mlstm_conv_b": nrm((N_ODD, 2 * D_QK_W), 0.02),
        "mlstm_i_bias": nrm((N_ODD, D_HEADS), 0.1),
        "mlstm_f_bias": 3.0 + nrm((N_ODD, D_HEADS), 0.5),
        "mlstm_h_norm_g": gain((N_ODD, D_VD)),
    }


def reference(x, mem, positions, ln_g, mem_norm_g, mem_w_kv, mem_q_norm_g, mem_k_norm_g, w_out,
              even_w_in, mla_q_lat_g, mla_kv_lat_g, mla_w_uq, mla_w_ukv, mla_q_norm_g, mla_k_norm_g,
              nsa_q_norm_g, nsa_k_norm_g, nsa_cmp_pos, nsa_cmp_w1, nsa_cmp_w2,
              odd_w_in, dsa_q_norm_g, dsa_k_norm_g,
              mlstm_conv_w, mlstm_conv_b, mlstm_i_bias, mlstm_f_bias, mlstm_h_norm_g):
    for layer in range(DEPTH):
        h = rms_norm(x, ln_g[layer])
        li = layer // 2
        if layer % 2 == 0:
            u = h @ even_w_in[li]
            (a_ql, a_kvl, a_kr, a_gate, b_q, b_kc, b_vc, b_ks, b_vs, b_kw, b_vw, b_g, b_gate,
             m_q, m_gate) = split_cols(u, EVEN_SIZES)
            y_a = mla_mixer(a_ql, a_kvl, a_kr, positions, mla_q_lat_g[li], mla_kv_lat_g[li],
                            mla_w_uq[li], mla_w_ukv[li], mla_q_norm_g[li], mla_k_norm_g[li])
            y_b = nsa_mixer(b_q, b_kc, b_vc, b_ks, b_vs, b_kw, b_vw, b_g, positions,
                            nsa_q_norm_g[li], nsa_k_norm_g[li], nsa_cmp_pos[li], nsa_cmp_w1[li], nsa_cmp_w2[li])
            y1 = y_a * jax.nn.silu(a_gate)
            y2 = y_b * jax.nn.silu(b_gate)
        else:
            u = h @ odd_w_in[li]
            (c_q, c_k, c_v, c_iq, c_ik, c_iw, c_gate, d_q, d_k, d_v, d_i, d_f, d_o, d_gate,
             m_q, m_gate) = split_cols(u, ODD_SIZES)
            y_c = dsa_mixer(c_q, c_k, c_v, c_iq, c_ik, c_iw, positions, dsa_q_norm_g[li], dsa_k_norm_g[li])
            y_d = mlstm_mixer(d_q, d_k, d_v, d_i, d_f, d_o, mlstm_conv_w[li], mlstm_conv_b[li],
                              mlstm_i_bias[li], mlstm_f_bias[li], mlstm_h_norm_g[li])
            y1 = y_c * jax.nn.silu(c_gate)
            y2 = y_d * jax.nn.silu(d_gate)
        y_m = mem_xattn(m_q, mem, mem_norm_g[layer], mem_w_kv[layer], mem_q_norm_g[layer], mem_k_norm_g[layer])
        mix = jnp.concatenate([y1, y2, y_m * jax.nn.silu(m_gate)], axis=-1)
        x = x + mix @ w_out[layer]
    return x
```

```cpp
#include <hip/hip_runtime.h>
#include <hip/hip_cooperative_groups.h>
#include <cstdio>
namespace cg = cooperative_groups;

#define DI __device__ __forceinline__
typedef unsigned short bf16_t;
typedef short bf16x8 __attribute__((ext_vector_type(8)));
typedef short s16x4 __attribute__((ext_vector_type(4)));
typedef float f32x16 __attribute__((ext_vector_type(16)));
typedef float f32x4 __attribute__((ext_vector_type(4)));
typedef float f32x2 __attribute__((ext_vector_type(2)));
typedef __bf16 bfv2 __attribute__((ext_vector_type(2)));
typedef unsigned u32x4 __attribute__((ext_vector_type(4)));

#ifndef PHASE_LIMIT
#define PHASE_LIMIT 1000
#endif

constexpr int S_ = 4096, NB = 8, T_ = NB * S_, DM = 1024;
constexpr int NPE = 3328, NPO = 4096;
constexpr float EPS = 1e-6f;
constexpr float NEGF = -1e30f;
constexpr float LOG2E = 1.4426950408889634f;
constexpr float MFLOOR = -30000.f;
constexpr int E_AQL = 0, E_AKVL = 256, E_AKR = 384, E_AGATE = 448, E_BQ = 960, E_BKC = 1472, E_BVC = 1600, E_BKS = 1728,
              E_BVS = 1856, E_BKW = 1984, E_BVW = 2112, E_BGATE = 2240, E_MQ = 2752, E_MGATE = 3008;
constexpr int O_CQ = 0, O_CK = 512, O_CV = 576, O_CIQ = 640, O_CIK = 896, O_CGATE = 960, O_DQ = 1472, O_DK = 1728, O_DV = 1984,
              O_DO = 2496, O_DGATE = 3008, O_MQ = 3520, O_MGATE = 3776;
constexpr int SMEM_BYTES = 70656;

struct Params {
  const float *x, *mem; const int* pos;
  const float *ln_g, *mem_norm_g, *mem_w_kv, *mem_q_g, *mem_k_g, *w_out, *even_w_in, *mla_q_lat_g, *mla_kv_lat_g, *mla_w_uq,
      *mla_w_ukv, *mla_q_norm_g, *mla_k_norm_g, *nsa_q_g, *nsa_k_g, *nsa_cmp_pos, *nsa_cmp_w1, *nsa_cmp_w2, *odd_w_in, *dsa_q_g,
      *dsa_k_g, *conv_w, *conv_b, *i_bias, *f_bias, *h_norm_g;
  float* out;
  bf16_t *WinT[4], *WoutT, *WuqT, *WukvT, *WmemT, *Wc1T, *memb, *U, *xb, *qbuf, *kbuf, *vbuf, *mix, *kcmp, *vcmp, *memk, *memv;
  unsigned* maskw;
  float *rope64, *rope32, *misc, *mU, *mN, *mS;
  unsigned* bar;
};

DI int tidx() { int t = threadIdx.x; asm volatile("" : "+v"(t)); return t; }
DI float bf2f(bf16_t v) { return __uint_as_float(((unsigned)v) << 16); }
DI unsigned pk2(float a, float b) { f32x2 v = {a, b}; bfv2 r = __builtin_convertvector(v, bfv2); return __builtin_bit_cast(unsigned, r); }
DI bf16_t f2bf(float a) { return (bf16_t)(pk2(a, 0.f) & 0xffffu); }
DI float bflo(unsigned u) { return __uint_as_float(u << 16); }
DI float bfhi(unsigned u) { return __uint_as_float(u & 0xffff0000u); }
DI int crow(int i, int h) { return (i & 3) + 8 * (i >> 2) + 4 * h; }
DI float siluf(float x) { return x / (1.f + __expf(-x)); }
DI float sigmf(float x) { return 1.f / (1.f + __expf(-x)); }
DI float ex2(float x) { return __builtin_amdgcn_exp2f(x); }
DI f32x16 mfma32(bf16x8 a, bf16x8 b, f32x16 c) { return __builtin_amdgcn_mfma_f32_32x32x16_bf16(a, b, c, 0, 0, 0); }
DI f32x16 zero16() { f32x16 z;
#pragma unroll
  for (int i = 0; i < 16; ++i) z[i] = 0.f; return z; }
DI bf16x8 pack8(const f32x16& x, int s) {
  u32x4 p; p.x = pk2(x[8 * s], x[8 * s + 1]); p.y = pk2(x[8 * s + 2], x[8 * s + 3]); p.z = pk2(x[8 * s + 4], x[8 * s + 5]); p.w = pk2(x[8 * s + 6], x[8 * s + 7]);
  return __builtin_bit_cast(bf16x8, p);
}
DI s16x4 trread(const bf16_t* p) {
  return __builtin_amdgcn_ds_read_tr16_b64_v4i16((s16x4 __attribute__((address_space(3)))*)(p));
}

DI int map_even(int n) { if (n < 416) return n; if (n < 448) return -1; if (n < 2240) return n - 32; if (n < 3264) return n - 8; if (n < 3288) return 2208 + (n - 3264); return -1; }
DI int map_odd(int n) { if (n < 928) return n; if (n < 960) return -1; if (n < 2496) return n - 24; if (n < 4032) return n - 16; if (n < 4040) return 928 + (n - 4032); if (n < 4048) return 2472 + (n - 4040); return -1; }
DI int map_uq(int n) { int h = n >> 7, c = n & 127; return c < 96 ? h * 96 + c : -1; }

template <int MAP>
DI void convT(bf16_t* dst, const float* src, const float* gain, int K, int Nsrc, int Npad, int gtid, int gsz) {
  int total = Npad * (K / 8);
  for (int i = gtid; i < total; i += gsz) {
    int n = (int)(i % Npad); int k0 = (int)(i / Npad) * 8;
    int sc = MAP == 0 ? n : MAP == 1 ? map_even(n) : MAP == 2 ? map_odd(n) : map_uq(n);
    u32x4 o = {0u, 0u, 0u, 0u};
    if (sc >= 0) {
      float v[8];
#pragma unroll
      for (int j = 0; j < 8; ++j) v[j] = src[(long)(k0 + j) * Nsrc + sc] * (gain ? gain[k0 + j] : 1.f);
      o.x = pk2(v[0], v[1]); o.y = pk2(v[2], v[3]); o.z = pk2(v[4], v[5]); o.w = pk2(v[6], v[7]);
    }
    *(u32x4*)(dst + (long)n * K + k0) = o;
  }
}

DI void cvt_rows(bf16_t* dst, const float* src, int n8, int gtid, int gsz) {
  for (int i = gtid; i < n8; i += gsz) {
    float4 a = ((const float4*)src)[2 * i], b = ((const float4*)src)[2 * i + 1];
    u32x4 o; o.x = pk2(a.x, a.y); o.y = pk2(a.z, a.w); o.z = pk2(b.x, b.y); o.w = pk2(b.z, b.w);
    ((u32x4*)dst)[i] = o;
  }
}

DI void phase0(const Params& p, int gtid, int gsz) {
  for (int l = 0; l < 4; ++l) {
    int li = l >> 1;
    if ((l & 1) == 0) convT<1>(p.WinT[l], p.even_w_in + (long)li * DM * 3256, p.ln_g + l * DM, DM, 3256, NPE, gtid, gsz);
    else convT<2>(p.WinT[l], p.odd_w_in + (long)li * DM * 4016, p.ln_g + l * DM, DM, 4016, NPO, gtid, gsz);
    convT<0>(p.WoutT + (long)l * 1024 * 1280, p.w_out + (long)l * 1280 * 1024, nullptr, 1280, 1024, 1024, gtid, gsz);
    convT<0>(p.WmemT + (long)l * 512 * 1024, p.mem_w_kv + (long)l * 1024 * 512, p.mem_norm_g + l * DM, 1024, 512, 512, gtid, gsz);
  }
  for (int li = 0; li < 2; ++li) {
    convT<3>(p.WuqT + (long)li * 1024 * 256, p.mla_w_uq + (long)li * 256 * 768, p.mla_q_lat_g + li * 256, 256, 768, 1024, gtid, gsz);
    convT<0>(p.WukvT + (long)li * 1024 * 128, p.mla_w_ukv + (long)li * 128 * 1024, p.mla_kv_lat_g + li * 128, 128, 1024, 1024, gtid, gsz);
    for (int kv = 0; kv < 2; ++kv)
      convT<0>(p.Wc1T + (long)(li * 2 + kv) * 64 * 2048, p.nsa_cmp_w1 + (long)(li * 2 + kv) * 2048 * 64, nullptr, 2048, 64, 64, gtid, gsz);
  }
  cvt_rows(p.xb, p.x, T_ * DM / 8, gtid, gsz);
  cvt_rows(p.memb, p.mem, NB * 256 * DM / 8, gtid, gsz);
  for (int i = gtid; i < T_ * 32; i += gsz) {
    int tok = (int)(i >> 5), f = (int)(i & 31);
    float ps = (float)p.pos[tok];
    float inv = powf(10000.f, -(float)f / 32.f);
    float ang = ps * inv;
    p.rope64[(long)i * 2] = cosf(ang); p.rope64[(long)i * 2 + 1] = sinf(ang);
    if (f < 16) {
      float inv2 = powf(10000.f, -(float)f / 16.f);
      float a2 = ps * inv2;
      p.rope32[((long)tok * 16 + f) * 2] = cosf(a2); p.rope32[((long)tok * 16 + f) * 2 + 1] = sinf(a2);
    }
  }
}

DI float sumsq8(u32x4 v) {
  float s = 0.f, t;
  t = bflo(v.x); s += t * t; t = bfhi(v.x); s += t * t; t = bflo(v.y); s += t * t; t = bfhi(v.y); s += t * t;
  t = bflo(v.z); s += t * t; t = bfhi(v.z); s += t * t; t = bflo(v.w); s += t * t; t = bfhi(v.w); s += t * t;
  return s;
}

template <bool ROWNORM, class Epi>
DI void gemm_tile(const bf16_t* __restrict__ A, int lda, const bf16_t* __restrict__ BT, int K, int m0, int n0, char* smem, Epi epi) {
  bf16_t* As = (bf16_t*)smem; bf16_t* Bs = As + 128 * 136;
  float* Cs = (float*)smem; float* rsc = (float*)(smem + 69632);
  const int tid = tidx(), lane = tid & 63, w = __builtin_amdgcn_readfirstlane(tid >> 6), wm = w >> 1, wn = w & 1, r = lane & 31, h = lane >> 5;
  const int lrow = tid >> 4, lkc = tid & 15;
  f32x16 acc[2][2];
#pragma unroll
  for (int i = 0; i < 2; ++i)
#pragma unroll
    for (int j = 0; j < 2; ++j) acc[i][j] = zero16();
  u32x4 ra[8], rb[8]; float ss[8] = {0.f, 0.f, 0.f, 0.f, 0.f, 0.f, 0.f, 0.f};
  const bf16_t* Ap = A + (long)(m0 + lrow) * lda + lkc * 8;
  const bf16_t* Bp = BT + (long)(n0 + lrow) * K + lkc * 8;
#pragma unroll
  for (int i = 0; i < 8; ++i) { ra[i] = *(const u32x4*)(Ap + (long)16 * i * lda); rb[i] = *(const u32x4*)(Bp + (long)16 * i * K); }
  const int nk = K >> 7;
  for (int kt = 0; kt < nk; ++kt) {
    __syncthreads();
#pragma unroll
    for (int i = 0; i < 8; ++i) {
      *(u32x4*)(As + (lrow + 16 * i) * 136 + lkc * 8) = ra[i];
      *(u32x4*)(Bs + (lrow + 16 * i) * 136 + lkc * 8) = rb[i];
      if (ROWNORM) ss[i] += sumsq8(ra[i]);
    }
    __syncthreads();
    if (kt + 1 < nk) {
#pragma unroll
      for (int i = 0; i < 8; ++i) { ra[i] = *(const u32x4*)(Ap + (long)16 * i * lda + (kt + 1) * 128); rb[i] = *(const u32x4*)(Bp + (long)16 * i * K + (kt + 1) * 128); }
    }
    {
      const bf16_t* Ar = As + (wm * 64 + r) * 136 + 8 * h;
      const bf16_t* Br = Bs + (wn * 64 + r) * 136 + 8 * h;
      bf16x8 fa[2][2], fb[2][2];
#pragma unroll
      for (int i = 0; i < 2; ++i) { fa[0][i] = *(const bf16x8*)(Ar + i * 32 * 136); fb[0][i] = *(const bf16x8*)(Br + i * 32 * 136); }
#pragma unroll
      for (int ks = 0; ks < 8; ++ks) {
        const int cu = ks & 1, nx = cu ^ 1;
        if (ks + 1 < 8) {
#pragma unroll
          for (int i = 0; i < 2; ++i) { fa[nx][i] = *(const bf16x8*)(Ar + i * 32 * 136 + (ks + 1) * 16); fb[nx][i] = *(const bf16x8*)(Br + i * 32 * 136 + (ks + 1) * 16); }
        }
#pragma unroll
        for (int i = 0; i < 2; ++i)
#pragma unroll
          for (int j = 0; j < 2; ++j) acc[i][j] = mfma32(fa[cu][i], fb[cu][j], acc[i][j]);
      }
    }
  }
  __syncthreads();
#pragma unroll
  for (int mi = 0; mi < 2; ++mi)
#pragma unroll
    for (int ni = 0; ni < 2; ++ni)
#pragma unroll
      for (int i = 0; i < 16; ++i) Cs[(wm * 64 + mi * 32 + crow(i, h)) * 132 + wn * 64 + ni * 32 + r] = acc[mi][ni][i];
  if (ROWNORM) {
#pragma unroll
    for (int i = 0; i < 8; ++i) {
      float sv = ss[i];
      sv += __shfl_xor(sv, 1); sv += __shfl_xor(sv, 2); sv += __shfl_xor(sv, 4); sv += __shfl_xor(sv, 8);
      if (lkc == 0) rsc[lrow + 16 * i] = rsqrtf(sv / (float)K + EPS);
    }
  }
  __syncthreads();
  {
    const int c8 = tid & 7, grp = (tid >> 3) & 1, rsub = tid >> 4;
    epi((n0 >> 6) + grp, c8, [&](auto body) {
#pragma unroll 2
      for (int pass = 0; pass < 8; ++pass) {
        int row = pass * 16 + rsub;
        body(m0 + row, Cs + row * 132 + grp * 64, ROWNORM ? rsc[row] : 1.f);
      }
    });
  }
}

DI void ld8(const float* p, float (&x)[8]) { *(float4*)&x[0] = ((const float4*)p)[0]; *(float4*)&x[4] = ((const float4*)p)[1]; }
DI void st8bf(bf16_t* dst, const float (&o)[8]) {
  u32x4 v; v.x = pk2(o[0], o[1]); v.y = pk2(o[2], o[3]); v.z = pk2(o[4], o[5]); v.w = pk2(o[6], o[7]);
  *(u32x4*)dst = v;
}
DI void ep_plain(const float* p, int c8, float sc, bf16_t* dst) {
  float x[8]; ld8(p + 8 * c8, x);
#pragma unroll
  for (int j = 0; j < 8; ++j) x[j] *= sc;
  st8bf(dst + 8 * c8, x);
}
DI void ep_zero(int c8, bf16_t* dst) { u32x4 z = {0u, 0u, 0u, 0u}; *(u32x4*)(dst + 8 * c8) = z; }
template <int HALF, bool NORM>
DI void ep_head(const float* p, int base, int lc, float rs, const float* g, const float* cs, bf16_t* dst) {
  constexpr int NL = HALF / 4;
  float x[8], xp[8], o[8];
  ld8(p + base + 8 * lc, x);
  const int pl = lc ^ (NL / 2);
  ld8(p + base + 8 * pl, xp);
  float sc = rs;
  if (NORM) {
    float ss = 0.f;
#pragma unroll
    for (int j = 0; j < 8; ++j) ss += x[j] * x[j];
#pragma unroll
    for (int d = 1; d < NL; d <<= 1) ss += __shfl_xor(ss, d);
    sc = rs * rsqrtf(ss * rs * rs * (1.f / (2 * HALF)) + EPS);
  }
  const bool lo = lc < NL / 2;
  const int i0 = 8 * (lc & (NL / 2 - 1));
#pragma unroll
  for (int j = 0; j < 8; ++j) {
    float xo = x[j] * sc, xq = xp[j] * sc;
    if (g) { xo *= g[8 * lc + j]; xq *= g[8 * pl + j]; }
    if (cs) {
      float co = cs[2 * (i0 + j)], si = cs[2 * (i0 + j) + 1];
      o[j] = lo ? (xo * co - xq * si) : (xq * si + xo * co);
    } else o[j] = xo;
  }
  st8bf(dst + base + 8 * lc, o);
}
DI void ep_norm64(const float* p, int c8, float rs, const float* g, const float* cs, bf16_t* dst) { ep_head<32, true>(p, 0, c8, rs, g, cs, dst); }

template <int NCT> struct FState { f32x16 o[NCT][2]; float m[NCT]; float l[NCT]; };
template <int NCT> DI void fs_init(FState<NCT>& st) {
#pragma unroll
  for (int a = 0; a < NCT; ++a) { st.m[a] = MFLOOR; st.l[a] = 0.f;
#pragma unroll
    for (int b = 0; b < 2; ++b) st.o[a][b] = zero16(); }
}
struct KVSrc { const bf16_t* k1; long ks1; const bf16_t* k2; long ks2; const bf16_t* v; long vs; };

template <int DQ>
DI void kv_load(const KVSrc& s, int key0, int nvalid, u32x4 (&kr)[DQ / 32], u32x4 (&vr)[2], int tid) {
  constexpr int CPR = DQ / 8;
#pragma unroll
  for (int i = 0; i < DQ / 32; ++i) {
    int c = tid + 256 * i; int row = c / CPR, cc = c % CPR; int key = key0 + row;
    u32x4 z = {0u, 0u, 0u, 0u};
    if (key < nvalid) {
      const bf16_t* ptr = (cc < 8) ? s.k1 + (long)key * s.ks1 + cc * 8 : s.k2 + (long)key * s.ks2 + (cc - 8) * 8;
      z = *(const u32x4*)ptr;
    }
    kr[i] = z;
  }
#pragma unroll
  for (int i = 0; i < 2; ++i) {
    int c = tid + 256 * i; int row = c >> 3, cc = c & 7; int key = key0 + row;
    u32x4 z = {0u, 0u, 0u, 0u};
    if (key < nvalid) z = *(const u32x4*)(s.v + (long)key * s.vs + cc * 8);
    vr[i] = z;
  }
}
template <int DQ>
DI void kv_store(bf16_t* Ks, bf16_t* Vs, const u32x4 (&kr)[DQ / 32], const u32x4 (&vr)[2], int tid) {
  constexpr int CPR = DQ / 8;
#pragma unroll
  for (int i = 0; i < DQ / 32; ++i) { int c = tid + 256 * i; int row = c / CPR, cc = c % CPR; *(u32x4*)(Ks + row * (DQ + 8) + cc * 8) = kr[i]; }
#pragma unroll
  for (int i = 0; i < 2; ++i) { int c = tid + 256 * i; int row = c >> 3, cc = c & 7; *(u32x4*)(Vs + row * 72 + cc * 8) = vr[i]; }
}

template <int DQ, bool MASKED, class MaskF>
DI void score_tile(const bf16_t* Ks, const bf16x8 (&qf)[DQ / 16], f32x16 (&s)[2], MaskF mask, int r, int h) {
#pragma unroll
  for (int sub = 0; sub < 2; ++sub) {
    f32x16 acc = zero16();
#pragma unroll
    for (int ks = 0; ks < DQ / 16; ++ks) {
      bf16x8 a = *(const bf16x8*)(Ks + (sub * 32 + r) * (DQ + 8) + ks * 16 + 8 * h);
      acc = mfma32(a, qf[ks], acc);
    }
    if (MASKED) {
#pragma unroll
      for (int i = 0; i < 16; ++i) acc[i] = mask(sub, i) ? acc[i] : NEGF;
    }
    s[sub] = acc;
  }
}

template <int DQ, int NCT, bool MASKED, class MaskF>
DI void flash_tile(const bf16_t* Ks, const bf16_t* Vs, const bf16x8 (&qf)[NCT][DQ / 16], FState<NCT>& st, float sc2, MaskF mask, int lane) {
  const int r = lane & 31, h = lane >> 5;
  const int q4 = (lane & 15) >> 2, pp = lane & 3, blk = (lane >> 4) & 1;
#pragma unroll
  for (int ct = 0; ct < NCT; ++ct) {
    bf16x8 pf[4];
    {
      f32x16 s[2];
      score_tile<DQ, MASKED>(Ks, qf[ct], s, [&](int sub, int i) { return mask(ct, sub, i); }, r, h);
      float mx = NEGF;
#pragma unroll
      for (int sub = 0; sub < 2; ++sub)
#pragma unroll
        for (int i = 0; i < 16; ++i) mx = fmaxf(mx, s[sub][i]);
      mx = fmaxf(mx, __shfl_xor(mx, 32));
      float mnew = fmaxf(st.m[ct], mx * sc2);
      float alpha = ex2(st.m[ct] - mnew);
      st.m[ct] = mnew;
      float rs = 0.f;
#pragma unroll
      for (int sub = 0; sub < 2; ++sub)
#pragma unroll
        for (int i = 0; i < 16; ++i) { float pv = ex2(fmaf(s[sub][i], sc2, -mnew)); s[sub][i] = pv; rs += pv; }
      rs += __shfl_xor(rs, 32);
      st.l[ct] = st.l[ct] * alpha + rs;
      if (__ballot(alpha != 1.f) != 0ull) {
#pragma unroll
        for (int d = 0; d < 2; ++d)
#pragma unroll
          for (int i = 0; i < 16; ++i) st.o[ct][d][i] *= alpha;
      }
#pragma unroll
      for (int sub = 0; sub < 2; ++sub)
#pragma unroll
        for (int s2 = 0; s2 < 2; ++s2) pf[sub * 2 + s2] = pack8(s[sub], s2);
    }
#pragma unroll
    for (int dvt = 0; dvt < 2; ++dvt)
#pragma unroll
      for (int f = 0; f < 4; ++f) {
        int keybase = (f >> 1) * 32 + (f & 1) * 16 + 4 * h;
        const bf16_t* vp = Vs + (keybase + q4) * 72 + dvt * 32 + 16 * blk + 4 * pp;
        s16x4 lo = trread(vp), hi = trread(vp + 8 * 72);
        bf16x8 vf = __builtin_shufflevector(lo, hi, 0, 1, 2, 3, 4, 5, 6, 7);
        st.o[ct][dvt] = mfma32(vf, pf[f], st.o[ct][dvt]);
      }
  }
}

DI void write_out(const f32x16 (&o)[2], float inv, const bf16_t* gate, bf16_t* dst, int h) {
#pragma unroll
  for (int dvt = 0; dvt < 2; ++dvt)
#pragma unroll
    for (int g4 = 0; g4 < 4; ++g4) {
      int dv = dvt * 32 + 8 * g4 + 4 * h;
      uint2 gv = *(const uint2*)(gate + dv);
      float y0 = o[dvt][4 * g4] * inv * siluf(bflo(gv.x)), y1 = o[dvt][4 * g4 + 1] * inv * siluf(bfhi(gv.x));
      float y2 = o[dvt][4 * g4 + 2] * inv * siluf(bflo(gv.y)), y3 = o[dvt][4 * g4 + 3] * inv * siluf(bfhi(gv.y));
      uint2 ov; ov.x = pk2(y0, y1); ov.y = pk2(y2, y3);
      *(uint2*)(dst + dv) = ov;
    }
}

template <int DQ>
DI void load_q(bf16x8 (&qf)[DQ / 16], const bf16_t* qrow, int h) {
#pragma unroll
  for (int ks = 0; ks < DQ / 16; ++ks) qf[ks] = *(const bf16x8*)(qrow + ks * 16 + 8 * h);
}

template <int DQ, int NCT, bool DB = false, class MaskF, class NeedF>
DI void attn_pass(const KVSrc& src, int kt0, int kt1, int nvalid, const bf16x8 (&qf)[NCT][DQ / 16], FState<NCT>& st, float sc2, MaskF mask, NeedF need, char* smem) {
  const int tid = tidx(), lane = tid & 63;
  u32x4 kr[DQ / 32], vr[2];
  if (!DB) {
    bf16_t* Ks = (bf16_t*)smem; bf16_t* Vs = (bf16_t*)(smem + 13312);
    if (kt0 < kt1) kv_load<DQ>(src, kt0 * 64, nvalid, kr, vr, tid);
    for (int kt = kt0; kt < kt1; ++kt) {
      __syncthreads();
      kv_store<DQ>(Ks, Vs, kr, vr, tid);
      __syncthreads();
      if (kt + 1 < kt1) kv_load<DQ>(src, (kt + 1) * 64, nvalid, kr, vr, tid);
      const int nd = need(kt);
      if (nd == 1) flash_tile<DQ, NCT, false>(Ks, Vs, qf, st, sc2, [&](int ct, int sub, int i) { return true; }, lane);
      else if (nd == 2) flash_tile<DQ, NCT, true>(Ks, Vs, qf, st, sc2, [&](int ct, int sub, int i) { return mask(kt, ct, sub, i); }, lane);
    }
  } else {
    if (kt0 >= kt1) return;
    kv_load<DQ>(src, kt0 * 64, nvalid, kr, vr, tid);
    __syncthreads();
    kv_store<DQ>((bf16_t*)smem, (bf16_t*)(smem + 13312), kr, vr, tid);
    __syncthreads();
    int cur = 0;
    for (int kt = kt0; kt < kt1; ++kt) {
      bf16_t* Ks = (bf16_t*)(smem + cur * 22528); bf16_t* Vs = (bf16_t*)(smem + cur * 22528 + 13312);
      const bool more = kt + 1 < kt1;
      if (more) kv_load<DQ>(src, (kt + 1) * 64, nvalid, kr, vr, tid);
      const int nd = need(kt);
      if (nd == 1) flash_tile<DQ, NCT, false>(Ks, Vs, qf, st, sc2, [&](int ct, int sub, int i) { return true; }, lane);
      else if (nd == 2) flash_tile<DQ, NCT, true>(Ks, Vs, qf, st, sc2, [&](int ct, int sub, int i) { return mask(kt, ct, sub, i); }, lane);
      if (more) kv_store<DQ>((bf16_t*)(smem + (cur ^ 1) * 22528), (bf16_t*)(smem + (cur ^ 1) * 22528 + 13312), kr, vr, tid);
      __syncthreads();
      cur ^= 1;
    }
  }
}

#ifndef MLA_NCT
#define MLA_NCT 1
#endif
#ifndef MEM_NCT
#define MEM_NCT 2
#endif
#ifndef DSA_NCT
#define DSA_NCT 2
#endif
DI void mla_item(const Params& p, int item, char* smem) {
  constexpr int NCT = MLA_NCT, NQB = 32 / NCT;
  const int qb = NQB - 1 - (item >> 6), bh = item & 63, b = bh >> 3, hd = bh & 7;
  const int tid = tidx(), lane = tid & 63, w = __builtin_amdgcn_readfirstlane(tid >> 6), r = lane & 31, h = lane >> 5;
  const int q0 = qb * 128 * NCT;
  int tq[NCT]; bf16x8 qf[NCT][6];
#pragma unroll
  for (int ct = 0; ct < NCT; ++ct) { tq[ct] = q0 + (w * NCT + ct) * 32 + r; load_q<96>(qf[ct], p.qbuf + ((long)b * S_ + tq[ct]) * 768 + hd * 96, h); }
  KVSrc src; src.k1 = p.kbuf + (long)b * S_ * 512 + hd * 64; src.ks1 = 512; src.k2 = p.U + (long)b * S_ * NPE + E_AKR; src.ks2 = NPE;
  src.v = p.vbuf + (long)b * S_ * 512 + hd * 64; src.vs = 512;
  FState<NCT> st; fs_init(st);
  const int wminq = q0 + w * NCT * 32, wmaxq = wminq + NCT * 32 - 1;
  const float sc2 = 0.10206207261596575f * LOG2E;
  attn_pass<96, NCT, true>(src, 0, (q0 + 128 * NCT) / 64, S_, qf, st, sc2,
                     [&](int kt, int ct, int sub, int i) { return kt * 64 + sub * 32 + crow(i, h) <= tq[ct]; },
                     [&](int kt) { return kt * 64 > wmaxq ? 0 : (kt * 64 + 63 <= wminq ? 1 : 2); }, smem);
#pragma unroll
  for (int ct = 0; ct < NCT; ++ct) {
    const long tok = (long)b * S_ + tq[ct];
    float inv = st.l[ct] > 0.f ? 1.f / st.l[ct] : 0.f;
    write_out(st.o[ct], inv, p.U + tok * NPE + E_AGATE + hd * 64, p.mix + tok * 1280 + hd * 64, h);
  }
}

DI void mem_item(const Params& p, int layer, int item, char* smem) {
  constexpr int NCT = MEM_NCT;
  const bool odd = layer & 1; const int NP = odd ? NPO : NPE, cq = odd ? O_MQ : E_MQ, cg_ = odd ? O_MGATE : E_MGATE;
  const int qb = item >> 5, bh = item & 31, b = bh >> 2, hd = bh & 3;
  const int tid = tidx(), lane = tid & 63, w = __builtin_amdgcn_readfirstlane(tid >> 6), r = lane & 31, h = lane >> 5;
  int tq[NCT]; bf16x8 qf[NCT][4];
#pragma unroll
  for (int ct = 0; ct < NCT; ++ct) { tq[ct] = qb * 128 * NCT + (w * NCT + ct) * 32 + r; load_q<64>(qf[ct], p.U + ((long)b * S_ + tq[ct]) * NP + cq + hd * 64, h); }
  KVSrc src; src.k1 = p.memk + ((long)(layer * NB + b) * 256) * 256 + hd * 64; src.ks1 = 256; src.k2 = src.k1; src.ks2 = 0;
  src.v = p.memv + ((long)(layer * NB + b) * 256) * 256 + hd * 64; src.vs = 256;
  FState<NCT> st; fs_init(st);
  attn_pass<64, NCT, true>(src, 0, 4, 256, qf, st, 0.125f * LOG2E, [&](int, int, int, int) { return true; }, [&](int) { return 1; }, smem);
#pragma unroll
  for (int ct = 0; ct < NCT; ++ct) {
    const long tok = (long)b * S_ + tq[ct];
    float inv = st.l[ct] > 0.f ? 1.f / st.l[ct] : 0.f;
    write_out(st.o[ct], inv, p.U + tok * NP + cg_ + hd * 64, p.mix + tok * 1280 + 1024 + hd * 64, h);
  }
}

DI void dsa_item(const Params& p, int item, char* smem) {
  constexpr int NCT = DSA_NCT, NQB = 256 / NCT;
  const int qb = NQB - 1 - (item >> 3), b = item & 7;
  const int tid = tidx(), lane = tid & 63, w = __builtin_amdgcn_readfirstlane(tid >> 6), r = lane & 31, h = lane >> 5;
  const int q0 = qb * 16 * NCT;
  int tq[NCT]; bf16x8 qf[NCT][4];
  const int hd = r & 7;
  const unsigned* mwb = p.maskw + (long)b * S_ * 128;
#pragma unroll
  for (int ct = 0; ct < NCT; ++ct) {
    tq[ct] = q0 + (w * NCT + ct) * 4 + (r >> 3);
    const long tok = (long)b * S_ + tq[ct];
    load_q<64>(qf[ct], p.U + tok * NPO + O_CQ + hd * 64, h);
  }
  KVSrc src; src.k1 = p.U + (long)b * S_ * NPO + O_CK; src.ks1 = NPO; src.k2 = src.k1; src.ks2 = 0; src.v = p.U + (long)b * S_ * NPO + O_CV; src.vs = NPO;
  FState<NCT> st; fs_init(st);
  attn_pass<64, NCT, false>(src, 0, (q0 + 16 * NCT - 1) / 64 + 1, S_, qf, st, 0.125f * LOG2E,
                     [&](int kt, int ct, int sub, int i) { unsigned wd = mwb[tq[ct] * 128 + kt * 2 + sub]; return ((wd >> crow(i, h)) & 1u) != 0u; },
                     [&](int) { return 2; }, smem);
#pragma unroll
  for (int ct = 0; ct < NCT; ++ct) {
    const long tok = (long)b * S_ + tq[ct];
    float inv = st.l[ct] > 0.f ? 1.f / st.l[ct] : 0.f;
    write_out(st.o[ct], inv, p.U + tok * NPO + O_CGATE + hd * 64, p.mix + tok * 1280 + hd * 64, h);
  }
}

DI void nsa_item(const Params& p, int item, char* smem) {
  const int qb = 127 - (item >> 4), bg = item & 15, b = bg >> 1, g = bg & 1;
  const int tid = tidx(), lane = tid & 63, w = __builtin_amdgcn_readfirstlane(tid >> 6), r = lane & 31, h = lane >> 5;
  const int q0 = qb * 32, cur = q0 >> 6;
  bf16_t* Ks = (bf16_t*)smem; bf16_t* Vs = (bf16_t*)(smem + 13312);
  float* imp = (float*)(smem + 22528);
  unsigned long long* selm = (unsigned long long*)(smem + 30720);
  unsigned long long* uni = (unsigned long long*)(smem + 30976);
  const int ql = w * 8 + (r >> 2), tq = q0 + ql, hd = g * 4 + (r & 3);
  const long tok = (long)b * S_ + tq;
  bf16x8 qf[1][4];
  load_q<64>(qf[0], p.U + tok * NPE + E_BQ + hd * 64, h);
  const float sc2 = 0.125f * LOG2E;
  float* oaccL = (float*)(smem + 32768) + tid;
  const float* gatep = p.misc + tok * 32 + hd * 3;
  for (int i = tid; i < 32 * 64; i += 256) imp[i] = 0.f;

  KVSrc csrc; csrc.k1 = p.kcmp + (long)b * 256 * 128 + g * 64; csrc.ks1 = 128; csrc.k2 = csrc.k1; csrc.ks2 = 0; csrc.v = p.vcmp + (long)b * 256 * 128 + g * 64; csrc.vs = 128;
  const int nmax = q0 >> 4;
  const int nct = (nmax >> 6) + 1;
  FState<1> st; fs_init(st);
  auto cmask = [&](int kt, int sub, int i) { int n = kt * 64 + sub * 32 + crow(i, h); return 16 * n + 31 <= tq; };
  attn_pass<64, 1>(csrc, 0, nct, 255, qf, st, sc2, [&](int kt, int, int sub, int i) { return cmask(kt, sub, i); }, [&](int) { return 2; }, smem);
  const float linv = st.l[0] > 0.f ? 1.f / st.l[0] : 0.f;
  const float mfin = st.m[0];
  const float g0l = sigmf(gatep[0]) * linv;
#pragma unroll
  for (int d = 0; d < 2; ++d)
#pragma unroll
    for (int i = 0; i < 16; ++i) oaccL[(d * 16 + i) * 256] = g0l * st.o[0][d][i];
  {
    u32x4 kr[2], vr[2];
    float carry = 0.f;
    for (int kt = 0; kt < nct; ++kt) {
      __syncthreads();
      kv_load<64>(csrc, kt * 64, 255, kr, vr, tid);
      kv_store<64>(Ks, Vs, kr, vr, tid);
      __syncthreads();
      f32x16 s[2];
      score_tile<64, true>(Ks, qf[0], s, [&](int sub, int i) { return cmask(kt, sub, i); }, r, h);
#pragma unroll
      for (int sub = 0; sub < 2; ++sub) {
        float pr[16];
#pragma unroll
        for (int i = 0; i < 16; ++i) pr[i] = ex2(fmaf(s[sub][i], sc2, -mfin)) * linv;
        float part[4];
#pragma unroll
        for (int g4 = 0; g4 < 4; ++g4) part[g4] = __shfl_xor(pr[4 * g4 + 3], 32);
#pragma unroll
        for (int g4 = 0; g4 < 4; ++g4) {
          float gs = pr[4 * g4] + pr[4 * g4 + 1] + pr[4 * g4 + 2] + pr[4 * g4 + 3];
          float ex = h ? part[g4] : (g4 > 0 ? part[g4 - 1] : carry);
          float v = gs + ex;
          v += __shfl_xor(v, 1); v += __shfl_xor(v, 2);
          int j = kt * 16 + sub * 8 + 2 * g4 + h;
          if ((r & 3) == 0) imp[ql * 64 + j] = v;
        }
        carry = part[3];
      }
    }
  }
  __syncthreads();
  {
    unsigned long long wun = 0ull;
    for (int qi = 0; qi < 8; ++qi) {
      int qq = w * 8 + qi; int t = q0 + qq;
      int j = lane;
      float forced = (j == cur) ? 3e4f : ((j == cur - 1) ? 2e4f : ((j == 0) ? 1e4f : 0.f));
      float sc = (64 * j <= t) ? imp[qq * 64 + j] + forced : NEGF;
      int rank = 0;
#pragma unroll
      for (int i = 0; i < 64; ++i) {
        float si = __uint_as_float(__builtin_amdgcn_readlane(__float_as_uint(sc), i));
        rank += (si > sc || (si == sc && i < j)) ? 1 : 0;
      }
      unsigned long long m = __ballot(rank < 16 && 64 * j <= t);
      if (lane == 0) selm[qq] = m;
      wun |= m;
    }
    if (lane == 0) uni[w] = wun;
  }
  __syncthreads();
  const unsigned long long un = uni[0] | uni[1] | uni[2] | uni[3];
  const unsigned long long sm = selm[ql];
  {
    KVSrc ssrc; ssrc.k1 = p.U + (long)b * S_ * NPE + E_BKS + g * 64; ssrc.ks1 = NPE; ssrc.k2 = ssrc.k1; ssrc.ks2 = 0; ssrc.v = p.U + (long)b * S_ * NPE + E_BVS + g * 64; ssrc.vs = NPE;
    fs_init(st);
    u32x4 kr[2], vr[2];
    unsigned long long rem = un;
    int j = rem ? __builtin_ctzll(rem) : -1;
    if (j >= 0) kv_load<64>(ssrc, j * 64, S_, kr, vr, tid);
    while (j >= 0) {
      rem &= rem - 1;
      int jn = rem ? __builtin_ctzll(rem) : -1;
      __syncthreads();
      kv_store<64>(Ks, Vs, kr, vr, tid);
      __syncthreads();
      if (jn >= 0) kv_load<64>(ssrc, jn * 64, S_, kr, vr, tid);
      bool b0 = (sm >> j) & 1ull;
      if (__ballot(b0) != 0ull)
        flash_tile<64, 1, true>(Ks, Vs, qf, st, sc2, [&](int, int sub, int i) { return b0 && (j * 64 + sub * 32 + crow(i, h) <= tq); }, lane);
      j = jn;
    }
    float li = (st.l[0] > 0.f ? 1.f / st.l[0] : 0.f) * sigmf(gatep[1]);
#pragma unroll
    for (int d = 0; d < 2; ++d)
#pragma unroll
      for (int i = 0; i < 16; ++i) oaccL[(d * 16 + i) * 256] += li * st.o[0][d][i];
  }
  {
    KVSrc wsrc; wsrc.k1 = p.U + (long)b * S_ * NPE + E_BKW + g * 64; wsrc.ks1 = NPE; wsrc.k2 = wsrc.k1; wsrc.ks2 = 0; wsrc.v = p.U + (long)b * S_ * NPE + E_BVW + g * 64; wsrc.vs = NPE;
    fs_init(st);
    int kt0 = q0 - 511 < 0 ? 0 : (q0 - 511) >> 6;
    attn_pass<64, 1>(wsrc, kt0, cur + 1, S_, qf, st, sc2,
                     [&](int kt, int, int sub, int i) { int key = kt * 64 + sub * 32 + crow(i, h); return key <= tq && key > tq - 512; },
                     [&](int kt) { return (kt * 64 + 63 <= q0 + w * 8 && kt * 64 > q0 + w * 8 + 7 - 512) ? 1 : 2; }, smem);
    float li = (st.l[0] > 0.f ? 1.f / st.l[0] : 0.f) * sigmf(gatep[2]);
#pragma unroll
    for (int d = 0; d < 2; ++d)
#pragma unroll
      for (int i = 0; i < 16; ++i) st.o[0][d][i] = oaccL[(d * 16 + i) * 256] + li * st.o[0][d][i];
  }
  write_out(st.o[0], 1.f, p.U + tok * NPE + E_BGATE + hd * 64, p.mix + tok * 1280 + 512 + hd * 64, h);
  __syncthreads();
}

DI void cmp_item(const Params& p, int li, int item, char* smem) {
  const int kv = item & 1, tile = item >> 1;
  const int tid = tidx(), lane = tid & 63, w = __builtin_amdgcn_readfirstlane(tid >> 6), r = lane & 31, h = lane >> 5;
  float* part = (float*)smem;
  float* h1 = (float*)(smem + 33280);
  float* o2 = (float*)(smem + 41600);
  const int idx = tile * 32 + r;
  const bool rv = idx < NB * 255 * 2;
  const int bb = rv ? idx / 510 : 0, rem = rv ? idx % 510 : 0, n = rem >> 1, g = rem & 1;
  const bf16_t* arow = p.U + ((long)(bb * S_ + 16 * n)) * NPE + (kv ? E_BVC : E_BKC) + g * 64;
  const float* pe = p.nsa_cmp_pos + (long)(li * 2 + kv) * 32 * 64;
  const bf16_t* W1 = p.Wc1T + (long)(li * 2 + kv) * 64 * 2048;
  f32x16 acc[2] = {zero16(), zero16()};
  for (int ks_ = 0; ks_ < 32; ++ks_) {
    int ks = ks_; asm volatile("" : "+s"(ks));
    int k = w * 512 + ks * 16 + 8 * h; int l = k >> 6, d = k & 63;
    u32x4 av = *(const u32x4*)(arow + (long)l * NPE + d);
    float4 pa = *(const float4*)(pe + l * 64 + d), pb = *(const float4*)(pe + l * 64 + d + 4);
    u32x4 af;
    af.x = pk2(bflo(av.x) + pa.x, bfhi(av.x) + pa.y); af.y = pk2(bflo(av.y) + pa.z, bfhi(av.y) + pa.w);
    af.z = pk2(bflo(av.z) + pb.x, bfhi(av.z) + pb.y); af.w = pk2(bflo(av.w) + pb.z, bfhi(av.w) + pb.w);
    bf16x8 a = __builtin_bit_cast(bf16x8, af);
#pragma unroll
    for (int nt = 0; nt < 2; ++nt) {
      bf16x8 bfr = *(const bf16x8*)(W1 + (long)(nt * 32 + r) * 2048 + k);
      acc[nt] = mfma32(a, bfr, acc[nt]);
    }
  }
  __syncthreads();
#pragma unroll
  for (int nt = 0; nt < 2; ++nt)
#pragma unroll
    for (int i = 0; i < 16; ++i) part[(w * 32 + crow(i, h)) * 65 + nt * 32 + r] = acc[nt][i];
  __syncthreads();
  for (int e = tid; e < 32 * 64; e += 256) {
    int rr = e >> 6, cc = e & 63;
    float v = part[rr * 65 + cc] + part[(32 + rr) * 65 + cc] + part[(64 + rr) * 65 + cc] + part[(96 + rr) * 65 + cc];
    h1[rr * 65 + cc] = siluf(v);
  }
  __syncthreads();
  {
    const float* W2 = p.nsa_cmp_w2 + (long)(li * 2 + kv) * 64 * 64;
    int rr = tid >> 3, c0 = (tid & 7) * 8;
    float o[8] = {0.f, 0.f, 0.f, 0.f, 0.f, 0.f, 0.f, 0.f};
    for (int i = 0; i < 64; ++i) {
      float hv = h1[rr * 65 + i];
      float4 wa = *(const float4*)(W2 + i * 64 + c0), wb = *(const float4*)(W2 + i * 64 + c0 + 4);
      o[0] += hv * wa.x; o[1] += hv * wa.y; o[2] += hv * wa.z; o[3] += hv * wa.w;
      o[4] += hv * wb.x; o[5] += hv * wb.y; o[6] += hv * wb.z; o[7] += hv * wb.w;
    }
#pragma unroll
    for (int j = 0; j < 8; ++j) o2[rr * 65 + c0 + j] = o[j];
  }
  __syncthreads();
  if (tid < 32) {
    int idx2 = tile * 32 + tid;
    if (idx2 < NB * 255 * 2) {
      int b2 = idx2 / 510, rem2 = idx2 % 510, n2 = rem2 >> 1, g2 = rem2 & 1;
      const float* row = o2 + tid * 65;
      bf16_t* dst = (kv ? p.vcmp : p.kcmp) + ((long)(b2 * 256 + n2)) * 128 + g2 * 64;
      if (kv) {
#pragma unroll 4
        for (int i = 0; i < 64; ++i) dst[i] = f2bf(row[i]);
      } else {
        float ss = 0.f;
#pragma unroll 4
        for (int i = 0; i < 64; ++i) ss += row[i] * row[i];
        float sc = rsqrtf(ss * (1.f / 64.f) + EPS);
        const float* gn = p.nsa_k_g + li * 192;
        const float* cs = p.rope64 + ((long)(b2 * S_ + 16 * n2 + 31)) * 64;
#pragma unroll 2
        for (int i = 0; i < 32; ++i) {
          float x1 = row[i] * sc * gn[i], x2 = row[i + 32] * sc * gn[i + 32];
          float co = cs[2 * i], si = cs[2 * i + 1];
          dst[i] = f2bf(x1 * co - x2 * si); dst[i + 32] = f2bf(x1 * si + x2 * co);
        }
      }
    }
  }
  __syncthreads();
}

DI unsigned mono(float f) { unsigned u = __float_as_uint(f); return (u & 0x80000000u) ? ~u : (u | 0x80000000u); }
DI int red32(int v) { v += __shfl_xor(v, 1); v += __shfl_xor(v, 2); v += __shfl_xor(v, 4); v += __shfl_xor(v, 8); v += __shfl_xor(v, 16); return v; }

DI void dsa_select_item(const Params& p, int item, char* smem) {
  const int idx_ = item >> 3, zk_ = idx_ >> 6, zj_ = idx_ & 63;
  const int b = item & 7, q8 = 511 - ((zk_ & 1) ? (zk_ * 64 + 63 - zj_) : idx_);
  const int tid_ = tidx();
  const int lane = tid_ & 63, w = __builtin_amdgcn_readfirstlane(tid_ >> 6);
  const int hq = lane >> 5, l16 = lane & 15, g16 = lane >> 4, bit = g16 & 1;
  const int tqa = q8 * 8 + 2 * w, tq = tqa + hq, tqb = tqa + 1;
  const long tokb = (long)b * S_;
  bf16x8 af = *(const bf16x8*)(p.U + (tokb + tqa + (l16 >> 3)) * NPO + O_CIQ + (l16 & 7) * 32 + 8 * g16);
  float iw[4];
#pragma unroll
  for (int j = 0; j < 4; ++j) iw[j] = p.misc[(tokb + tq) * 32 + bit * 4 + j] * 0.35355339059327373f;
  unsigned ku[64];
  unsigned* kl = (unsigned*)smem + w * 4096 + lane;
  const int imax = tqb >> 5;
  const char* ikb = (const char*)(p.U + tokb * NPO + O_CIK);
  const unsigned voff = (unsigned)(l16 * NPO + 8 * g16) * 2u;
  auto score = [&](int i) -> unsigned {
    const char* sb = ikb + (size_t)i * (32 * NPO * 2);
    bf16x8 b0 = *(const bf16x8*)(sb + voff);
    bf16x8 b1 = *(const bf16x8*)(sb + 16 * NPO * 2 + voff);
    f32x4 z = {0.f, 0.f, 0.f, 0.f};
    f32x4 c0 = __builtin_amdgcn_mfma_f32_16x16x32_bf16(af, b0, z, 0, 0, 0);
    f32x4 c1 = __builtin_amdgcn_mfma_f32_16x16x32_bf16(af, b1, z, 0, 0, 0);
    float sA = iw[0] * fmaxf(c0[0], 0.f) + iw[1] * fmaxf(c0[1], 0.f) + iw[2] * fmaxf(c0[2], 0.f) + iw[3] * fmaxf(c0[3], 0.f);
    float sB = iw[0] * fmaxf(c1[0], 0.f) + iw[1] * fmaxf(c1[1], 0.f) + iw[2] * fmaxf(c1[2], 0.f) + iw[3] * fmaxf(c1[3], 0.f);
    float keep = bit ? sB : sA, send = bit ? sA : sB;
    float sc = keep + __shfl_xor(send, 16);
    int key = 32 * i + (lane & 31);
    return mono(key <= tq ? sc : NEGF);
  };
#pragma unroll
  for (int c = 0; c < 8; ++c) {
    if (8 * c <= imax) {
#pragma unroll
      for (int j = 0; j < 8; ++j) ku[8 * c + j] = score(8 * c + j);
    } else {
#pragma unroll
      for (int j = 0; j < 8; ++j) ku[8 * c + j] = 0u;
    }
  }
  const int iend = imax < 64 ? 63 : (imax | 3);
  for (int i = 64; i <= iend; i += 4) {
    unsigned k0 = score(i), k1 = score(i + 1), k2 = score(i + 2), k3 = score(i + 3);
    kl[(i - 64) * 64] = k0; kl[(i - 63) * 64] = k1; kl[(i - 62) * 64] = k2; kl[(i - 61) * 64] = k3;
  }
  unsigned thr = 0u; int need = 1 << 20;
  unsigned* mw = p.maskw + (tokb + tq) * 128;
  const unsigned lowmask = (1u << (lane & 31)) - 1u;
  int run = 0;
  auto emit = [&](int i, unsigned kv) {
    bool eq = kv == thr, gt = kv > thr;
    unsigned long long bal = __ballot(eq);
    unsigned mine = hq ? (unsigned)(bal >> 32) : (unsigned)bal;
    int pre = __popc(mine & lowmask);
    bool sel = gt || (eq && (run + pre < need));
    run += __popc(mine);
    sel = sel && (32 * i + (lane & 31) <= tq);
    unsigned long long sb = __ballot(sel);
    unsigned word = hq ? (unsigned)(sb >> 32) : (unsigned)sb;
    if ((lane & 31) == 0) mw[i] = word;
  };
  if (imax < 64) {
    if (tqa >= 256) {
      bool done = false;
      for (int bt = 31; bt >= 0; --bt) {
        unsigned cand = thr | (1u << bt);
        int cnt = 0;
#pragma unroll
        for (int i = 0; i < 64; ++i) cnt += (ku[i] >= cand) ? 1 : 0;
        cnt = red32(cnt);
        if (!done) { thr = cnt >= 256 ? cand : thr; done = (cnt == 256); }
        if (__all(done)) break;
      }
      int cg = 0;
#pragma unroll
      for (int i = 0; i < 64; ++i) cg += (ku[i] > thr) ? 1 : 0;
      need = 256 - red32(cg);
    }
#pragma unroll
    for (int i = 0; i < 64; ++i) emit(i, ku[i]);
    for (int i = 64; i < 128; ++i) { if ((lane & 31) == 0) mw[i] = 0u; }
  } else {
    unsigned k2[64];
#pragma unroll
    for (int j = 0; j < 64; ++j) { unsigned v = kl[j * 64]; k2[j] = (64 + j <= iend) ? v : 0u; }
    bool done = false;
    for (int bt = 31; bt >= 0; --bt) {
      unsigned cand = thr | (1u << bt);
      int cnt = 0;
#pragma unroll
      for (int i = 0; i < 64; ++i) cnt += ((ku[i] >= cand) ? 1 : 0) + ((k2[i] >= cand) ? 1 : 0);
      cnt = red32(cnt);
      if (!done) { thr = cnt >= 256 ? cand : thr; done = (cnt == 256); }
      if (__all(done)) break;
    }
    int cg = 0;
#pragma unroll
    for (int i = 0; i < 64; ++i) cg += ((ku[i] > thr) ? 1 : 0) + ((k2[i] > thr) ? 1 : 0);
    need = 256 - red32(cg);
#pragma unroll
    for (int i = 0; i < 64; ++i) emit(i, ku[i]);
#pragma unroll
    for (int i = 0; i < 64; ++i) emit(64 + i, k2[i]);
  }
}

DI f32x16 mfmaf(float a, float b, f32x16 c) { return __builtin_amdgcn_mfma_f32_32x32x2f32(a, b, c, 0, 0, 0); }

DI void mlstm_stage(const Params& p, int li, int hd, long t0, int cidx, float* QW, float* Kl, float* Vl, bool needq, int tid, int w, int lane) {
  const float* cw = p.conv_w + (long)li * 4 * 512; const float* cb = p.conv_b + li * 512;
  const int d = lane;
#pragma unroll
  for (int which = 0; which < 2; ++which) {
    if (which == 0 && !needq) continue;
    int ch = which * 256 + hd * 64 + d;
    const bf16_t* up = p.U + t0 * NPO + (which ? O_DK : O_DQ) + hd * 64 + d;
    float w0 = cw[ch], w1 = cw[512 + ch], w2 = cw[1024 + ch], w3 = cw[1536 + ch], bias = cb[ch];
    int tl0 = w * 16;
    int s0 = cidx * 64 + tl0;
    float x0 = (s0 - 3 >= 0) ? bf2f(up[(long)(tl0 - 3) * NPO]) : 0.f;
    float x1 = (s0 - 2 >= 0) ? bf2f(up[(long)(tl0 - 2) * NPO]) : 0.f;
    float x2 = (s0 - 1 >= 0) ? bf2f(up[(long)(tl0 - 1) * NPO]) : 0.f;
    float* dstl = which ? Kl : QW;
#pragma unroll 4
    for (int i = 0; i < 16; ++i) {
      float x3 = bf2f(up[(long)(tl0 + i) * NPO]);
      float y = bias + w0 * x0 + w1 * x1 + w2 * x2 + w3 * x3;
      y = siluf(y);
      if (which) y *= 0.125f;
      dstl[(tl0 + i) * 65 + d] = y;
      x0 = x1; x1 = x2; x2 = x3;
    }
  }
#pragma unroll
  for (int i = 0; i < 4; ++i) {
    int cidx2 = tid + 256 * i; int tl = cidx2 >> 4, vc8 = (cidx2 & 15) * 8;
    u32x4 vv = *(const u32x4*)(p.U + (t0 + tl) * NPO + O_DV + hd * 128 + vc8);
    float4 a, bq;
    a.x = bflo(vv.x); a.y = bfhi(vv.x); a.z = bflo(vv.y); a.w = bfhi(vv.y);
    bq.x = bflo(vv.z); bq.y = bfhi(vv.z); bq.z = bflo(vv.w); bq.w = bfhi(vv.w);
    *(float4*)(Vl + tl * 128 + vc8) = a; *(float4*)(Vl + tl * 128 + vc8 + 4) = bq;
  }
}

DI void mlstm_x(const Params& p, int li, int item, char* smem) {
  const int c = item & 63, bh = item >> 6, b = bh >> 2, hd = bh & 3;
  const int tid = tidx(), lane = tid & 63, w = __builtin_amdgcn_readfirstlane(tid >> 6), r = lane & 31, h = lane >> 5;
  float* Kl = (float*)(smem + 16640); float* Vl = (float*)(smem + 33280); float* vws = (float*)(smem + 66048);
  const long t0 = (long)b * S_ + c * 64;
  const float ib = p.i_bias[li * 4 + hd], fb = p.f_bias[li * 4 + hd];
  mlstm_stage(p, li, hd, t0, c, nullptr, Kl, Vl, false, tid, w, lane);
  if (w == 0) {
    float ig = p.misc[(t0 + lane) * 32 + 8 + hd] + ib;
    float fp = p.misc[(t0 + lane) * 32 + 12 + hd] + fb;
    float lf = fminf(fp, 0.f) - log1pf(__expf(-fabsf(fp)));
    float bc = lf;
#pragma unroll
    for (int dlt = 1; dlt < 64; dlt <<= 1) { float t = __shfl_up(bc, dlt); if (lane >= dlt) bc += t; }
    float bL = __shfl(bc, 63);
    float g = bL - bc + ig;
    float gm = g;
#pragma unroll
    for (int dlt = 1; dlt < 64; dlt <<= 1) gm = fmaxf(gm, __shfl_xor(gm, dlt));
    vws[lane] = __expf(g - gm);
    if (lane == 0) { p.mS[(long)item * 4] = bL; p.mS[(long)item * 4 + 1] = gm; }
  }
  __syncthreads();
  f32x16 acc[2] = {zero16(), zero16()};
#pragma unroll
  for (int dt = 0; dt < 2; ++dt)
#pragma unroll 4
    for (int kk = 0; kk < 32; ++kk) {
      int s = 2 * kk + h;
      float a = Kl[s * 65 + dt * 32 + r] * vws[s];
      float bb = Vl[s * 128 + 32 * w + r];
      acc[dt] = mfmaf(a, bb, acc[dt]);
    }
  float* Ug = p.mU + (long)item * 8192 + 32 * w + r;
#pragma unroll
  for (int dt = 0; dt < 2; ++dt)
#pragma unroll
    for (int i = 0; i < 16; ++i) Ug[(dt * 32 + crow(i, h)) * 128] = acc[dt][i];
  if (w == 1) {
    float ns = 0.f;
    for (int s = 0; s < 64; ++s) ns += Kl[s * 65 + lane] * vws[s];
    p.mN[(long)item * 64 + lane] = ns;
  }
}

DI void mlstm_y(const Params& p, int item) {
  const int tid = tidx();
  const long base = (long)item * 64;
  f32x4 C[8], uc[8], un[8];
#pragma unroll
  for (int j = 0; j < 8; ++j) { C[j] = (f32x4){0.f, 0.f, 0.f, 0.f}; un[j] = C[j]; }
  float nn = 0.f, m = 0.f;
  float* Ub = p.mU + base * 8192 + tid * 32;
#pragma unroll
  for (int j = 0; j < 8; ++j) uc[j] = *(const f32x4*)(Ub + 4 * j);
  for (int c = 0; c < 64; ++c) {
    float bL = p.mS[(base + c) * 4], ml = p.mS[(base + c) * 4 + 1];
    float* Uc = Ub + (long)c * 8192;
    if (c + 1 < 64) {
#pragma unroll
      for (int j = 0; j < 8; ++j) un[j] = *(const f32x4*)(Uc + 8192 + 4 * j);
    }
    float mnew = fmaxf(bL + m, ml);
    float decay = __expf(bL + m - mnew), sc = __expf(ml - mnew);
#pragma unroll
    for (int j = 0; j < 8; ++j) { *(f32x4*)(Uc + 4 * j) = C[j]; C[j] = decay * C[j] + sc * uc[j]; uc[j] = un[j]; }
    if (tid == 0) p.mS[(base + c) * 4 + 2] = m;
    if (tid < 64) { float nu = p.mN[(base + c) * 64 + tid]; p.mN[(base + c) * 64 + tid] = nn; nn = decay * nn + sc * nu; }
    m = mnew;
  }
}

DI void mlstm_z(const Params& p, int li, int item, char* smem) {
  const int c = item & 63, bh = item >> 6, b = bh >> 2, hd = bh & 3;
  const int tid = tidx(), lane = tid & 63, w = __builtin_amdgcn_readfirstlane(tid >> 6), r = lane & 31, h = lane >> 5;
  float* QW = (float*)smem;
  float* Kl = (float*)(smem + 16640);
  float* Vl = (float*)(smem + 33280);
  float* vb = (float*)(smem + 66048);
  float* vc = vb + 64; float* vmt = vb + 128; float* va = vb + 192; float* nvec = vb + 320; float* vinv = vb + 384;
  const long t0 = (long)b * S_ + c * 64;
  const float ib = p.i_bias[li * 4 + hd], fb = p.f_bias[li * 4 + hd];
  mlstm_stage(p, li, hd, t0, c, QW, Kl, Vl, true, tid, w, lane);
  if (tid < 64) nvec[tid] = p.mN[(long)item * 64 + tid];
  if (w == 0) {
    const float mstate = p.mS[(long)item * 4 + 2];
    float ig = p.misc[(t0 + lane) * 32 + 8 + hd] + ib;
    float fp = p.misc[(t0 + lane) * 32 + 12 + hd] + fb;
    float lf = fminf(fp, 0.f) - log1pf(__expf(-fabsf(fp)));
    float bc = lf;
#pragma unroll
    for (int dlt = 1; dlt < 64; dlt <<= 1) { float t = __shfl_up(bc, dlt); if (lane >= dlt) bc += t; }
    float cc = ig - bc;
    float pm = cc;
#pragma unroll
    for (int dlt = 1; dlt < 64; dlt <<= 1) { float t = __shfl_up(pm, dlt); if (lane >= dlt) pm = fmaxf(pm, t); }
    float mt = bc + fmaxf(mstate, pm);
    float aa = __expf(bc + mstate - mt);
    vb[lane] = bc; vc[lane] = cc; vmt[lane] = mt; va[lane] = aa;
  }
  __syncthreads();
  float qn = 0.f;
  if (w == 0) { for (int d = 0; d < 64; ++d) qn += QW[lane * 65 + d] * nvec[d]; }
  f32x16 hacc[2] = {zero16(), zero16()};
  {
    const float* Cg = p.mU + (long)item * 8192 + 32 * w + r;
#pragma unroll 8
    for (int kk = 0; kk < 32; ++kk) {
      float bb = Cg[(2 * kk + h) * 128];
      float a0 = QW[r * 65 + 2 * kk + h], a1 = QW[(32 + r) * 65 + 2 * kk + h];
      hacc[0] = mfmaf(a0, bb, hacc[0]);
      hacc[1] = mfmaf(a1, bb, hacc[1]);
    }
  }
  f32x16 sacc = zero16();
  const int tt_s = w >> 1, st_s = w & 1;
#pragma unroll 4
  for (int kk = 0; kk < 32; ++kk) {
    float a = QW[(tt_s * 32 + r) * 65 + 2 * kk + h];
    float bb = Kl[(st_s * 32 + r) * 65 + 2 * kk + h];
    sacc = mfmaf(a, bb, sacc);
  }
  __syncthreads();
  {
    int s = st_s * 32 + r; float cs_ = vc[s];
#pragma unroll
    for (int i = 0; i < 16; ++i) {
      int t = tt_s * 32 + crow(i, h);
      float wv = (s <= t) ? sacc[i] * __expf(vb[t] - vmt[t] + cs_) : 0.f;
      QW[t * 65 + s] = wv;
    }
  }
  __syncthreads();
#pragma unroll
  for (int tt = 0; tt < 2; ++tt)
#pragma unroll
    for (int i = 0; i < 16; ++i) hacc[tt][i] *= va[tt * 32 + crow(i, h)];
#pragma unroll 4
  for (int kk = 0; kk < 32; ++kk) {
    float bb = Vl[(2 * kk + h) * 128 + 32 * w + r];
    float a0 = QW[r * 65 + 2 * kk + h], a1 = QW[(32 + r) * 65 + 2 * kk + h];
    hacc[0] = mfmaf(a0, bb, hacc[0]);
    hacc[1] = mfmaf(a1, bb, hacc[1]);
  }
  if (w == 0) {
    float rsum = 0.f;
    for (int s = 0; s < 64; ++s) rsum += QW[lane * 65 + s];
    float den = va[lane] * qn + rsum;
    float dn = fmaxf(fabsf(den), __expf(-vmt[lane]));
    vinv[lane] = 1.f / dn;
  }
  __syncthreads();
#pragma unroll
  for (int tt = 0; tt < 2; ++tt)
#pragma unroll
    for (int i = 0; i < 16; ++i) { int t = tt * 32 + crow(i, h); Vl[t * 128 + 32 * w + r] = hacc[tt][i] * vinv[t]; }
  __syncthreads();
  {
    int t = tid >> 2, q = tid & 3;
    const float* hr = Vl + t * 128 + q * 32;
    float ss = 0.f;
#pragma unroll
    for (int i = 0; i < 8; ++i) { float4 v = ((const float4*)hr)[i]; ss += v.x * v.x + v.y * v.y + v.z * v.z + v.w * v.w; }
    ss += __shfl_xor(ss, 1); ss += __shfl_xor(ss, 2);
    float rn = rsqrtf(ss * (1.f / 128.f) + EPS);
    const float* gn = p.h_norm_g + li * 128 + q * 32;
    const bf16_t* op = p.U + (t0 + t) * NPO + O_DO + hd * 128 + q * 32;
    const bf16_t* gp = p.U + (t0 + t) * NPO + O_DGATE + hd * 128 + q * 32;
    bf16_t* dst = p.mix + (t0 + t) * 1280 + 512 + hd * 128 + q * 32;
#pragma unroll
    for (int cch = 0; cch < 4; ++cch) {
      u32x4 ov = *(const u32x4*)(op + cch * 8), gv = *(const u32x4*)(gp + cch * 8);
      float y[8];
#pragma unroll
      for (int j = 0; j < 8; ++j) y[j] = hr[cch * 8 + j] * rn * gn[cch * 8 + j];
      y[0] *= sigmf(bflo(ov.x)) * siluf(bflo(gv.x)); y[1] *= sigmf(bfhi(ov.x)) * siluf(bfhi(gv.x));
      y[2] *= sigmf(bflo(ov.y)) * siluf(bflo(gv.y)); y[3] *= sigmf(bfhi(ov.y)) * siluf(bfhi(gv.y));
      y[4] *= sigmf(bflo(ov.z)) * siluf(bflo(gv.z)); y[5] *= sigmf(bfhi(ov.z)) * siluf(bfhi(gv.z));
      y[6] *= sigmf(bflo(ov.w)) * siluf(bflo(gv.w)); y[7] *= sigmf(bfhi(ov.w)) * siluf(bfhi(gv.w));
      u32x4 o; o.x = pk2(y[0], y[1]); o.y = pk2(y[2], y[3]); o.z = pk2(y[4], y[5]); o.w = pk2(y[6], y[7]);
      *(u32x4*)(dst + cch * 8) = o;
    }
  }
}

DI int inproj_count(int layer) { return 256 * (((layer & 1) ? NPO : NPE) / 128) + (layer == 0 ? 256 : 0); }
DI void inproj_task(const Params& p, int layer, int t, char* smem) {
  const bool odd = layer & 1; const int li = layer >> 1;
  const int NP = odd ? NPO : NPE; const int ntn = NP / 128; const int nin = 256 * ntn;
#define ROWF [&](int row, const float* v, float rs)
  if (t < nin) {
    int mt = t / ntn, nt = t % ntn;
    if (!odd) {
      gemm_tile<true>(p.xb, DM, p.WinT[layer], DM, mt * 128, nt * 128, smem, [&](int gi, int c8, auto run) {
        bf16_t* d0 = p.U + gi * 64;
        auto n64 = [&](const float* g, bool rope) {
          if (rope) run(ROWF { ep_norm64(v, c8, rs, g, p.rope64 + (long)row * 64, d0 + (long)row * NPE); });
          else run(ROWF { ep_norm64(v, c8, rs, g, nullptr, d0 + (long)row * NPE); });
        };
        if (gi == 6) {
          if (c8 < 4) run(ROWF { ep_head<16, true>(v, 0, c8, rs, p.mla_k_norm_g + li * 96 + 64, p.rope32 + (long)row * 32, d0 + (long)row * NPE); });
          else run(ROWF { ep_zero(c8, d0 + (long)row * NPE); });
        }
        else if (gi >= 15 && gi < 23) n64(p.nsa_q_g + li * 64, true);
        else if (gi == 27 || gi == 28) n64(p.nsa_k_g + li * 192 + 64, true);
        else if (gi == 31 || gi == 32) n64(p.nsa_k_g + li * 192 + 128, true);
        else if (gi >= 43 && gi < 47) n64(p.mem_q_g + layer * 64, false);
        else if (gi == 51) { if (c8 < 3) run(ROWF { float x[8]; ld8(v + 8 * c8, x);
#pragma unroll
            for (int j = 0; j < 8; ++j) p.misc[(long)row * 32 + 8 * c8 + j] = x[j] * rs; }); }
        else run(ROWF { ep_plain(v, c8, rs, d0 + (long)row * NPE); });
      });
    } else {
      gemm_tile<true>(p.xb, DM, p.WinT[layer], DM, mt * 128, nt * 128, smem, [&](int gi, int c8, auto run) {
        bf16_t* d0 = p.U + gi * 64;
        if (gi <= 8) { const float* g = (gi < 8 ? p.dsa_q_g : p.dsa_k_g) + li * 64;
          run(ROWF { ep_norm64(v, c8, rs, g, p.rope64 + (long)row * 64, d0 + (long)row * NPO); }); }
        else if (gi >= 10 && gi < 14) run(ROWF { ep_head<16, false>(v, (c8 >> 2) * 32, c8 & 3, rs, nullptr, p.rope32 + (long)row * 32, d0 + (long)row * NPO); });
        else if (gi == 14) {
          if (c8 < 4) run(ROWF { ep_head<16, false>(v, 0, c8, rs, nullptr, p.rope32 + (long)row * 32, d0 + (long)row * NPO); });
          else run(ROWF { ep_zero(c8, d0 + (long)row * NPO); });
        }
        else if (gi >= 55 && gi < 59) { const float* g = p.mem_q_g + layer * 64; run(ROWF { ep_norm64(v, c8, rs, g, nullptr, d0 + (long)row * NPO); }); }
        else if (gi == 63) { if (c8 < 2) run(ROWF { float x[8]; ld8(v + 8 * c8, x);
#pragma unroll
            for (int j = 0; j < 8; ++j) p.misc[(long)row * 32 + 8 * c8 + j] = x[j] * rs; }); }
        else run(ROWF { ep_plain(v, c8, rs, d0 + (long)row * NPO); });
      });
    }
  } else {
    int u = t - nin; int l = u >> 6, mt = (u >> 2) & 15, nt = u & 3;
    gemm_tile<true>(p.memb, DM, p.WmemT + (long)l * 512 * 1024, DM, mt * 128, nt * 128, smem, [&](int gi, int c8, auto run) {
      if (gi < 4) run(ROWF { ep_norm64(v, c8, rs, p.mem_k_g + l * 64, nullptr, p.memk + ((long)l * 2048 + row) * 256 + gi * 64); });
      else run(ROWF { ep_plain(v, c8, rs, p.memv + ((long)l * 2048 + row) * 256 + (gi - 4) * 64); });
    });
  }
}
constexpr int NPREP = 2048 + 2048 + 256;
DI void prep_task(const Params& p, int li, int t, char* smem) {
  const int ncmp = 256, nuq = 2048;
  if (t < ncmp) {
    __syncthreads();
    cmp_item(p, li, t, smem);
  } else if (t < ncmp + nuq) {
    int u0 = t - ncmp; int mt = u0 >> 3, hd = u0 & 7;
    gemm_tile<true>(p.U + E_AQL, NPE, p.WuqT + (long)li * 1024 * 256, 256, mt * 128, hd * 128, smem, [&](int gi, int c8, auto run) {
      bf16_t* d0 = p.qbuf + hd * 96;
      if ((gi & 1) == 0) run(ROWF { ep_norm64(v, c8, rs, p.mla_q_norm_g + li * 96, nullptr, d0 + (long)row * 768); });
      else if (c8 < 4) run(ROWF { ep_head<16, true>(v, 0, c8, rs, p.mla_q_norm_g + li * 96 + 64, p.rope32 + (long)row * 32, d0 + (long)row * 768 + 64); });
    });
  } else {
    int u = t - ncmp - nuq; int mt = u >> 3, hd = u & 7;
    gemm_tile<true>(p.U + E_AKVL, NPE, p.WukvT + (long)li * 1024 * 128, 128, mt * 128, hd * 128, smem, [&](int gi, int c8, auto run) {
      if ((gi & 1) == 0) run(ROWF { ep_norm64(v, c8, rs, p.mla_k_norm_g + li * 96, nullptr, p.kbuf + (long)row * 512 + hd * 64); });
      else run(ROWF { ep_plain(v, c8, rs, p.vbuf + (long)row * 512 + hd * 64); });
    });
  }
}
DI void outproj_task(const Params& p, int layer, int t, char* smem) {
  const float* xold = (layer == 0) ? p.x : p.out;
  int mt = t >> 3, nt = t & 7;
  gemm_tile<false>(p.mix, 1280, p.WoutT + (long)layer * 1024 * 1280, 1280, mt * 128, nt * 128, smem, [&](int gi, int c8, auto run) {
    run(ROWF {
      const long o = (long)row * DM + gi * 64 + 8 * c8;
      float x[8]; ld8(v + 8 * c8, x);
      float4 xa = *(const float4*)(xold + o), xb2 = *(const float4*)(xold + o + 4);
      x[0] += xa.x; x[1] += xa.y; x[2] += xa.z; x[3] += xa.w; x[4] += xb2.x; x[5] += xb2.y; x[6] += xb2.z; x[7] += xb2.w;
      *(float4*)(p.out + o) = *(float4*)&x[0]; *(float4*)(p.out + o + 4) = *(float4*)&x[4];
      st8bf(p.xb + o, x);
    });
  });
}
#undef ROWF

typedef const __attribute__((address_space(4))) Params* KParams;
DI const Params& kparams() {
  KParams kp = (KParams)__builtin_amdgcn_kernarg_segment_ptr();
  asm volatile("" : "+s"(kp));
  return *(const Params*)kp;
}
DI int snake(int k, int t0, int bid, int nb, int total) { int tr = k * nb + (nb - 1 - bid); return ((k & 1) && (k + 1) * nb <= total) ? tr : t0; }
#define XB_TMO      128
#define XB_XCNT(j)  (256  + 64 * (j))
#define XB_XSUB(j)  (1280 + 64 * (j))
#define XB_XGEN(j)  (2304 + 64 * (j))
#define XB_TOP      3328
#define XB_TOPGEN   3392
#define XCD_BAR_WORDS 3456
#define XB_SPIN_CAP (1u << 22)
#define LAS __attribute__((address_space(3)))
DI unsigned xb_ld(unsigned* p) { return __hip_atomic_load(p, __ATOMIC_RELAXED, __HIP_MEMORY_SCOPE_AGENT); }
DI unsigned xb_add(unsigned* p, unsigned v) { return __hip_atomic_fetch_add(p, v, __ATOMIC_RELAXED, __HIP_MEMORY_SCOPE_AGENT); }
DI unsigned xb_xcc_id() { return (unsigned)__builtin_amdgcn_s_getreg((3 << 11) | 20) & 0xFu; }
#define XB_SPIN(cond, bar) do { unsigned _sp = 0; while (cond) { __builtin_amdgcn_s_sleep(1); \
    if ((++_sp & 255u) == 0u) { if (xb_ld(&(bar)[XB_TMO])) break; if (_sp > XB_SPIN_CAP) { atomicAdd(&(bar)[XB_TMO], 1u); break; } } } } while (0)
struct XcdBarrier { unsigned* bar; unsigned x; volatile LAS unsigned* st; };
DI XcdBarrier xcd_barrier_post(unsigned* bar, volatile LAS unsigned* st) {
  XcdBarrier b; b.bar = bar; b.x = xb_xcc_id(); b.st = st;
  if (threadIdx.x == 0) (void)xb_add(&bar[XB_XCNT(b.x)], 1u);
  return b;
}
DI void xcd_barrier_complete(unsigned* bar, unsigned x, unsigned& nloc, unsigned& nx) {
  const unsigned G = gridDim.x * gridDim.y * gridDim.z;
  unsigned sum, cnt, mine, sp = 0u;
  for (;;) {
    sum = 0u; cnt = 0u; mine = 0u;
#pragma unroll
    for (unsigned j = 0; j < 16; ++j) { const unsigned c = xb_ld(&bar[XB_XCNT(j)]); sum += c; cnt += (c > 0u) ? 1u : 0u; mine = (j == x) ? c : mine; }
    if (sum == G) break;
    __builtin_amdgcn_s_sleep(1);
    if ((++sp & 255u) == 0u) { if (xb_ld(&bar[XB_TMO])) break; if (sp > XB_SPIN_CAP) { atomicAdd(&bar[XB_TMO], 1u); break; } }
  }
  nloc = mine > 0u ? mine : 1u; nx = cnt > 0u ? cnt : 1u;
}
DI void xcd_barrier(const XcdBarrier& b) {
  asm volatile("s_waitcnt vmcnt(0)" ::: "memory");
  __syncthreads();
  if (threadIdx.x == 0) {
    unsigned* bar = b.bar;
    __builtin_amdgcn_s_waitcnt(0);
    unsigned nloc = b.st[0], nx = b.st[1];
    if (nloc == 0u) { xcd_barrier_complete(bar, b.x, nloc, nx); b.st[0] = nloc; b.st[1] = nx; }
    const unsigned old = xb_add(&bar[XB_XSUB(b.x)], 1u);
    const unsigned gen = old / nloc;
    if (old + 1u == (gen + 1u) * nloc) {
      __builtin_amdgcn_fence(__ATOMIC_RELEASE, "agent");
      asm volatile("s_waitcnt vmcnt(0)" ::: "memory");
      const unsigned og = xb_add(&bar[XB_TOP], 1u);
      const unsigned tg = og / nx;
      if (og + 1u == (tg + 1u) * nx) xb_add(&bar[XB_TOPGEN], 1u);
      else XB_SPIN(xb_ld(&bar[XB_TOPGEN]) == tg, bar);
      __builtin_amdgcn_fence(__ATOMIC_ACQUIRE, "agent");
      xb_add(&bar[XB_XGEN(b.x)], 1u);
      asm volatile("s_waitcnt vmcnt(0)" ::: "memory");
    } else {
      XB_SPIN(xb_ld(&bar[XB_XGEN(b.x)]) == gen, bar);
      __builtin_amdgcn_fence(__ATOMIC_ACQUIRE, "agent");
      asm volatile("s_waitcnt vmcnt(0)" ::: "memory");
    }
  }
  __syncthreads();
}
#define SMEM_DECL __shared__ __attribute__((aligned(16))) char smem[SMEM_BYTES]
__global__ void __launch_bounds__(256, 2) mega(Params p_) {
  SMEM_DECL;
  cg::grid_group grid = cg::this_grid();
  const int bid = blockIdx.x, nb = gridDim.x;
  int phase = 0;
#define PSYNC() do { ++phase; XcdBarrier xb_; xb_.bar = kparams().bar; xb_.x = xb_xcc_id(); xb_.st = (volatile LAS unsigned*)(smem + 70400); xcd_barrier(xb_); if (phase >= PHASE_LIMIT) return; } while (0)
  { const Params& p = kparams(); phase0(p, bid * 256 + tidx(), nb * 256);
    if (bid == 0) for (int i = threadIdx.x; i < XCD_BAR_WORDS; i += 256) __hip_atomic_store(p.bar + i, 0u, __ATOMIC_RELAXED, __HIP_MEMORY_SCOPE_AGENT); }
  if (threadIdx.x < 4) ((volatile unsigned*)(smem + 70400))[threadIdx.x] = 0u;
  grid.sync();
  (void)xcd_barrier_post(kparams().bar, (volatile LAS unsigned*)(smem + 70400));
  for (int layer = 0; layer < 4; ++layer) {
    const bool odd = layer & 1; const int li = layer >> 1;
    { const Params& p = kparams();
      const int ntn = (odd ? NPO : NPE) / 128;
      if ((nb & 7) == 0) {
        const int xcd = bid & 7, per = nb >> 3, tot = 32 * ntn;
        for (int j = bid >> 3; j < tot; j += per) {
          int mg = j / (8 * ntn), rem = j - mg * 8 * ntn, nt = rem >> 3, mi = rem & 7;
          inproj_task(p, layer, (xcd * 32 + mg * 8 + mi) * ntn + nt, smem);
        }
      } else {
        for (int t = bid; t < 256 * ntn; t += nb) inproj_task(p, layer, t, smem);
      }
      if (layer == 0) for (int t = bid; t < 256; t += nb) inproj_task(p, layer, 256 * ntn + t, smem);
    }
    PSYNC();
    if (!odd) {
      { const Params& p = kparams(); for (int t = bid; t < NPREP; t += nb) prep_task(p, li, t, smem); }
      PSYNC();
      { const Params& p = kparams(); for (int k = 0, t0 = bid; t0 < 2048 / MLA_NCT; ++k, t0 += nb) { int t = snake(k, t0, bid, nb, 2048 / MLA_NCT); __syncthreads(); mla_item(p, t, smem); } }
      { const Params& p = kparams(); for (int k = 0, t0 = bid; t0 < 2048; ++k, t0 += nb) { int t = snake(k, t0, bid, nb, 2048); __syncthreads(); nsa_item(p, t, smem); } }
      { const Params& p = kparams(); for (int t = bid; t < 1024 / MEM_NCT; t += nb) { __syncthreads(); mem_item(p, layer, t, smem); } }
      PSYNC();
    } else {
      { const Params& p = kparams();
        for (int t = bid; t < 2048 + 4096; t += nb) {
          __syncthreads();
          if (t < 2048) mlstm_x(p, li, t, smem); else dsa_select_item(p, t - 2048, smem);
        } }
      PSYNC();
      if (bid < 32) { const Params& p = kparams(); mlstm_y(p, bid); }
      if (bid >= 32) { const Params& p = kparams(); const int nb2 = nb - 32, b2 = bid - 32;
        for (int k = 0, t0 = b2; t0 < 2048 / DSA_NCT; ++k, t0 += nb2) { int t = snake(k, t0, b2, nb2, 2048 / DSA_NCT); __syncthreads(); dsa_item(p, t, smem); } }
      { const Params& p = kparams(); for (int t = bid; t < 1024 / MEM_NCT; t += nb) { __syncthreads(); mem_item(p, layer, t, smem); } }
      PSYNC();
      { const Params& p = kparams(); for (int t = bid; t < 2048; t += nb) { __syncthreads(); mlstm_z(p, li, t, smem); } }
      PSYNC();
    }
    { const Params& p = kparams();
      if ((nb & 7) == 0) {
        const int xcd = bid & 7, per = nb >> 3;
        for (int j = bid >> 3; j < 256; j += per) {
          int mg = j >> 6, rem = j & 63, nt = rem >> 3, mi = rem & 7;
          outproj_task(p, layer, (xcd * 32 + mg * 8 + mi) * 8 + nt, smem);
        }
      } else {
        for (int t = bid; t < 2048; t += nb) outproj_task(p, layer, t, smem);
      }
    }
    if (layer < 3) PSYNC();
  }
}

extern "C" void kernel_launch(void* const* d_in, const int* in_sizes, int n_in, void* d_out, int out_size, void* d_ws, size_t ws_size,
                              hipStream_t stream) {
  Params p{};
  const float* const* fin = (const float* const*)d_in;
  p.x = fin[0]; p.mem = fin[1]; p.pos = (const int*)d_in[2];
  p.ln_g = fin[3]; p.mem_norm_g = fin[4]; p.mem_w_kv = fin[5]; p.mem_q_g = fin[6]; p.mem_k_g = fin[7]; p.w_out = fin[8];
  p.even_w_in = fin[9]; p.mla_q_lat_g = fin[10]; p.mla_kv_lat_g = fin[11]; p.mla_w_uq = fin[12]; p.mla_w_ukv = fin[13];
  p.mla_q_norm_g = fin[14]; p.mla_k_norm_g = fin[15]; p.nsa_q_g = fin[16]; p.nsa_k_g = fin[17]; p.nsa_cmp_pos = fin[18];
  p.nsa_cmp_w1 = fin[19]; p.nsa_cmp_w2 = fin[20]; p.odd_w_in = fin[21]; p.dsa_q_g = fin[22]; p.dsa_k_g = fin[23];
  p.conv_w = fin[24]; p.conv_b = fin[25]; p.i_bias = fin[26]; p.f_bias = fin[27]; p.h_norm_g = fin[28];
  p.out = (float*)d_out;
  char* ws = (char*)d_ws; size_t off = 0;
  auto take = [&](size_t bytes) { char* r = ws + off; off += (bytes + 255) & ~(size_t)255; return r; };
  const size_t MB = 1u << 20;
  char* U = take(336 * MB);
  p.U = (bf16_t*)U; p.qbuf = (bf16_t*)(U + 208 * MB); p.xb = (bf16_t*)(U + 256 * MB); p.kbuf = (bf16_t*)(U + 256 * MB); p.vbuf = (bf16_t*)(U + 288 * MB);
  p.maskw = (unsigned*)(U + 256 * MB); p.mU = (float*)(U + 272 * MB);
  p.mix = (bf16_t*)take((size_t)T_ * 1280 * 2);
  for (int l = 0; l < 4; ++l) p.WinT[l] = (bf16_t*)take((size_t)((l & 1) ? NPO : NPE) * 1024 * 2);
  p.WoutT = (bf16_t*)take((size_t)4 * 1024 * 1280 * 2);
  p.WuqT = (bf16_t*)take((size_t)2 * 1024 * 256 * 2);
  p.WukvT = (bf16_t*)take((size_t)2 * 1024 * 128 * 2);
  p.WmemT = (bf16_t*)take((size_t)4 * 512 * 1024 * 2);
  p.Wc1T = (bf16_t*)take((size_t)4 * 64 * 2048 * 2);
  p.memb = (bf16_t*)take((size_t)NB * 256 * 1024 * 2);
  p.kcmp = (bf16_t*)take((size_t)NB * 256 * 128 * 2);
  p.vcmp = (bf16_t*)take((size_t)NB * 256 * 128 * 2);
  p.memk = (bf16_t*)take((size_t)4 * 2048 * 256 * 2);
  p.memv = (bf16_t*)take((size_t)4 * 2048 * 256 * 2);
  p.rope64 = (float*)take((size_t)T_ * 64 * 4);
  p.rope32 = (float*)take((size_t)T_ * 32 * 4);
  p.misc = (float*)take((size_t)T_ * 32 * 4);
  p.mN = (float*)take((size_t)2048 * 64 * 4);
  p.mS = (float*)take((size_t)2048 * 4 * 4);
  p.bar = (unsigned*)take(XCD_BAR_WORDS * 4);
  if (off > ws_size) { fprintf(stderr, "workspace too small: need %zu have %zu\n", off, ws_size); return; }
  static int grid_blocks = 0;
  if (!grid_blocks) {
    int dev = 0, cus = 0, per_cu = 0;
    (void)hipGetDevice(&dev);
    (void)hipDeviceGetAttribute(&cus, hipDeviceAttributeMultiprocessorCount, dev);
    (void)hipOccupancyMaxActiveBlocksPerMultiprocessor(&per_cu, mega, 256, 0);
    if (per_cu > 2) per_cu = 2;
    if (per_cu < 1) per_cu = 1;
    grid_blocks = cus * per_cu;
  }
  void* args[] = {&p};
  hipError_t e = hipLaunchCooperativeKernel((void*)mega, dim3(grid_blocks), dim3(256), args, 0, stream);
  if (e != hipSuccess) fprintf(stderr, "cooperative launch failed: %s (grid %d)\n", hipGetErrorString(e), grid_blocks);
}
```

```cpp
#include <hip/hip_runtime.h>
#include <hip/hip_cooperative_groups.h>
#include <cstdio>
namespace cg = cooperative_groups;

#define DI __device__ __forceinline__
typedef unsigned short bf16_t;
typedef short bf16x8 __attribute__((ext_vector_type(8)));
typedef short s16x4 __attribute__((ext_vector_type(4)));
typedef float f32x16 __attribute__((ext_vector_type(16)));
typedef float f32x4 __attribute__((ext_vector_type(4)));
typedef float f32x2 __attribute__((ext_vector_type(2)));
typedef __bf16 bfv2 __attribute__((ext_vector_type(2)));
typedef unsigned u32x4 __attribute__((ext_vector_type(4)));

#ifndef PHASE_LIMIT
#define PHASE_LIMIT 1000
#endif

constexpr int S_ = 4096, NB = 8, T_ = NB * S_, DM = 1024;
constexpr int NPE = 3328, NPO = 4096;
constexpr float EPS = 1e-6f;
constexpr float NEGF = -1e30f;
constexpr float LOG2E = 1.4426950408889634f;
constexpr float MFLOOR = -30000.f;
constexpr int E_AQL = 0, E_AKVL = 256, E_AKR = 384, E_AGATE = 448, E_BQ = 960, E_BKC = 1472, E_BVC = 1600, E_BKS = 1728,
              E_BVS = 1856, E_BKW = 1984, E_BVW = 2112, E_BGATE = 2240, E_MQ = 2752, E_MGATE = 3008;
constexpr int O_CQ = 0, O_CK = 512, O_CV = 576, O_CIQ = 640, O_CIK = 896, O_CGATE = 960, O_DQ = 1472, O_DK = 1728, O_DV = 1984,
              O_DO = 2496, O_DGATE = 3008, O_MQ = 3520, O_MGATE = 3776;
constexpr int SMEM_BYTES = 70656;

struct Params {
  const float *x, *mem; const int* pos;
  const float *ln_g, *mem_norm_g, *mem_w_kv, *mem_q_g, *mem_k_g, *w_out, *even_w_in, *mla_q_lat_g, *mla_kv_lat_g, *mla_w_uq,
      *mla_w_ukv, *mla_q_norm_g, *mla_k_norm_g, *nsa_q_g, *nsa_k_g, *nsa_cmp_pos, *nsa_cmp_w1, *nsa_cmp_w2, *odd_w_in, *dsa_q_g,
      *dsa_k_g, *conv_w, *conv_b, *i_bias, *f_bias, *h_norm_g;
  float* out;
  bf16_t *WinT[4], *WoutT, *WuqT, *WukvT, *WmemT, *Wc1T, *memb, *U, *xb, *qbuf, *kbuf, *vbuf, *mix, *kcmp, *vcmp, *memk, *memv;
  unsigned* maskw;
  float *rope64, *rope32, *misc, *mU, *mN, *mS;
  unsigned* bar;
};

DI int tidx() { int t = threadIdx.x; asm volatile("" : "+v"(t)); return t; }
DI float bf2f(bf16_t v) { return __uint_as_float(((unsigned)v) << 16); }
DI unsigned pk2(float a, float b) { f32x2 v = {a, b}; bfv2 r = __builtin_convertvector(v, bfv2); return __builtin_bit_cast(unsigned, r); }
DI bf16_t f2bf(float a) { return (bf16_t)(pk2(a, 0.f) & 0xffffu); }
DI float bflo(unsigned u) { return __uint_as_float(u << 16); }
DI float bfhi(unsigned u) { return __uint_as_float(u & 0xffff0000u); }
DI int crow(int i, int h) { return (i & 3) + 8 * (i >> 2) + 4 * h; }
DI float siluf(float x) { return x / (1.f + __expf(-x)); }
DI float sigmf(float x) { return 1.f / (1.f + __expf(-x)); }
DI float ex2(float x) { return __builtin_amdgcn_exp2f(x); }
DI f32x16 mfma32(bf16x8 a, bf16x8 b, f32x16 c) { return __builtin_amdgcn_mfma_f32_32x32x16_bf16(a, b, c, 0, 0, 0); }
DI f32x16 zero16() { f32x16 z;
#pragma unroll
  for (int i = 0; i < 16; ++i) z[i] = 0.f; return z; }
DI bf16x8 pack8(const f32x16& x, int s) {
  u32x4 p; p.x = pk2(x[8 * s], x[8 * s + 1]); p.y = pk2(x[8 * s + 2], x[8 * s + 3]); p.z = pk2(x[8 * s + 4], x[8 * s + 5]); p.w = pk2(x[8 * s + 6], x[8 * s + 7]);
  return __builtin_bit_cast(bf16x8, p);
}
DI s16x4 trread(const bf16_t* p) {
  return __builtin_amdgcn_ds_read_tr16_b64_v4i16((s16x4 __attribute__((address_space(3)))*)(p));
}

DI int map_even(int n) { if (n < 416) return n; if (n < 448) return -1; if (n < 2240) return n - 32; if (n < 3264) return n - 8; if (n < 3288) return 2208 + (n - 3264); return -1; }
DI int map_odd(int n) { if (n < 928) return n; if (n < 960) return -1; if (n < 2496) return n - 24; if (n < 4032) return n - 16; if (n < 4040) return 928 + (n - 4032); if (n < 4048) return 2472 + (n - 4040); return -1; }
DI int map_uq(int n) { int h = n >> 7, c = n & 127; return c < 96 ? h * 96 + c : -1; }

template <int MAP>
DI void convT(bf16_t* dst, const float* src, const float* gain, int K, int Nsrc, int Npad, int gtid, int gsz) {
  int total = Npad * (K / 8);
  for (int i = gtid; i < total; i += gsz) {
    int n = (int)(i % Npad); int k0 = (int)(i / Npad) * 8;
    int sc = MAP == 0 ? n : MAP == 1 ? map_even(n) : MAP == 2 ? map_odd(n) : map_uq(n);
    u32x4 o = {0u, 0u, 0u, 0u};
    if (sc >= 0) {
      float v[8];
#pragma unroll
      for (int j = 0; j < 8; ++j) v[j] = src[(long)(k0 + j) * Nsrc + sc] * (gain ? gain[k0 + j] : 1.f);
      o.x = pk2(v[0], v[1]); o.y = pk2(v[2], v[3]); o.z = pk2(v[4], v[5]); o.w = pk2(v[6], v[7]);
    }
    *(u32x4*)(dst + (long)n * K + k0) = o;
  }
}

DI void cvt_rows(bf16_t* dst, const float* src, int n8, int gtid, int gsz) {
  for (int i = gtid; i < n8; i += gsz) {
    float4 a = ((const float4*)src)[2 * i], b = ((const float4*)src)[2 * i + 1];
    u32x4 o; o.x = pk2(a.x, a.y); o.y = pk2(a.z, a.w); o.z = pk2(b.x, b.y); o.w = pk2(b.z, b.w);
    ((u32x4*)dst)[i] = o;
  }
}

DI void phase0(const Params& p, int gtid, int gsz) {
  for (int l = 0; l < 4; ++l) {
    int li = l >> 1;
    if ((l & 1) == 0) convT<1>(p.WinT[l], p.even_w_in + (long)li * DM * 3256, p.ln_g + l * DM, DM, 3256, NPE, gtid, gsz);
    else convT<2>(p.WinT[l], p.odd_w_in + (long)li * DM * 4016, p.ln_g + l * DM, DM, 4016, NPO, gtid, gsz);
    convT<0>(p.WoutT + (long)l * 1024 * 1280, p.w_out + (long)l * 1280 * 1024, nullptr, 1280, 1024, 1024, gtid, gsz);
    convT<0>(p.WmemT + (long)l * 512 * 1024, p.mem_w_kv + (long)l * 1024 * 512, p.mem_norm_g + l * DM, 1024, 512, 512, gtid, gsz);
  }
  for (int li = 0; li < 2; ++li) {
    convT<3>(p.WuqT + (long)li * 1024 * 256, p.mla_w_uq + (long)li * 256 * 768, p.mla_q_lat_g + li * 256, 256, 768, 1024, gtid, gsz);
    convT<0>(p.WukvT + (long)li * 1024 * 128, p.mla_w_ukv + (long)li * 128 * 1024, p.mla_kv_lat_g + li * 128, 128, 1024, 1024, gtid, gsz);
    for (int kv = 0; kv < 2; ++kv)
      convT<0>(p.Wc1T + (long)(li * 2 + kv) * 64 * 2048, p.nsa_cmp_w1 + (long)(li * 2 + kv) * 2048 * 64, nullptr, 2048, 64, 64, gtid, gsz);
  }
  cvt_rows(p.xb, p.x, T_ * DM / 8, gtid, gsz);
  cvt_rows(p.memb, p.mem, NB * 256 * DM / 8, gtid, gsz);
  for (int i = gtid; i < T_ * 32; i += gsz) {
    int tok = (int)(i >> 5), f = (int)(i & 31);
    float ps = (float)p.pos[tok];
    float inv = powf(10000.f, -(float)f / 32.f);
    float ang = ps * inv;
    p.rope64[(long)i * 2] = cosf(ang); p.rope64[(long)i * 2 + 1] = sinf(ang);
    if (f < 16) {
      float inv2 = powf(10000.f, -(float)f / 16.f);
      float a2 = ps * inv2;
      p.rope32[((long)tok * 16 + f) * 2] = cosf(a2); p.rope32[((long)tok * 16 + f) * 2 + 1] = sinf(a2);
    }
  }
}

DI float sumsq8(u32x4 v) {
  float s = 0.f, t;
  t = bflo(v.x); s += t * t; t = bfhi(v.x); s += t * t; t = bflo(v.y); s += t * t; t = bfhi(v.y); s += t * t;
  t = bflo(v.z); s += t * t; t = bfhi(v.z); s += t * t; t = bflo(v.w); s += t * t; t = bfhi(v.w); s += t * t;
  return s;
}

template <bool ROWNORM, class Epi>
DI void gemm_tile(const bf16_t* __restrict__ A, int lda, const bf16_t* __restrict__ BT, int K, int m0, int n0, char* smem, Epi epi) {
  bf16_t* As = (bf16_t*)smem; bf16_t* Bs = As + 128 * 136;
  float* Cs = (float*)smem; float* rsc = (float*)(smem + 69632);
  const int tid = tidx(), lane = tid & 63, w = __builtin_amdgcn_readfirstlane(tid >> 6), wm = w >> 1, wn = w & 1, r = lane & 31, h = lane >> 5;
  const int lrow = tid >> 4, lkc = tid & 15;
  f32x16 acc[2][2];
#pragma unroll
  for (int i = 0; i < 2; ++i)
#pragma unroll
    for (int j = 0; j < 2; ++j) acc[i][j] = zero16();
  u32x4 ra[8], rb[8]; float ss[8] = {0.f, 0.f, 0.f, 0.f, 0.f, 0.f, 0.f, 0.f};
  const bf16_t* Ap = A + (long)(m0 + lrow) * lda + lkc * 8;
  const bf16_t* Bp = BT + (long)(n0 + lrow) * K + lkc * 8;
#pragma unroll
  for (int i = 0; i < 8; ++i) { ra[i] = *(const u32x4*)(Ap + (long)16 * i * lda); rb[i] = *(const u32x4*)(Bp + (long)16 * i * K); }
  const int nk = K >> 7;
  for (int kt = 0; kt < nk; ++kt) {
    __syncthreads();
#pragma unroll
    for (int i = 0; i < 8; ++i) {
      *(u32x4*)(As + (lrow + 16 * i) * 136 + lkc * 8) = ra[i];
      *(u32x4*)(Bs + (lrow + 16 * i) * 136 + lkc * 8) = rb[i];
      if (ROWNORM) ss[i] += sumsq8(ra[i]);
    }
    __syncthreads();
    if (kt + 1 < nk) {
#pragma unroll
      for (int i = 0; i < 8; ++i) { ra[i] = *(const u32x4*)(Ap + (long)16 * i * lda + (kt + 1) * 128); rb[i] = *(const u32x4*)(Bp + (long)16 * i * K + (kt + 1) * 128); }
    }
    {
      const bf16_t* Ar = As + (wm * 64 + r) * 136 + 8 * h;
      const bf16_t* Br = Bs + (wn * 64 + r) * 136 + 8 * h;
      bf16x8 fa[2][2], fb[2][2];
#pragma unroll
      for (int i = 0; i < 2; ++i) { fa[0][i] = *(const bf16x8*)(Ar + i * 32 * 136); fb[0][i] = *(const bf16x8*)(Br + i * 32 * 136); }
#pragma unroll
      for (int ks = 0; ks < 8; ++ks) {
        const int cu = ks & 1, nx = cu ^ 1;
        if (ks + 1 < 8) {
#pragma unroll
          for (int i = 0; i < 2; ++i) { fa[nx][i] = *(const bf16x8*)(Ar + i * 32 * 136 + (ks + 1) * 16); fb[nx][i] = *(const bf16x8*)(Br + i * 32 * 136 + (ks + 1) * 16); }
        }
#pragma unroll
        for (int i = 0; i < 2; ++i)
#pragma unroll
          for (int j = 0; j < 2; ++j) acc[i][j] = mfma32(fa[cu][i], fb[cu][j], acc[i][j]);
      }
    }
  }
  __syncthreads();
#pragma unroll
  for (int mi = 0; mi < 2; ++mi)
#pragma unroll
    for (int ni = 0; ni < 2; ++ni)
#pragma unroll
      for (int i = 0; i < 16; ++i) Cs[(wm * 64 + mi * 32 + crow(i, h)) * 132 + wn * 64 + ni * 32 + r] = acc[mi][ni][i];
  if (ROWNORM) {
#pragma unroll
    for (int i = 0; i < 8; ++i) {
      float sv = ss[i];
      sv += __shfl_xor(sv, 1); sv += __shfl_xor(sv, 2); sv += __shfl_xor(sv, 4); sv += __shfl_xor(sv, 8);
      if (lkc == 0) rsc[lrow + 16 * i] = rsqrtf(sv / (float)K + EPS);
    }
  }
  __syncthreads();
  {
    const int c8 = tid & 7, grp = (tid >> 3) & 1, rsub = tid >> 4;
    epi((n0 >> 6) + grp, c8, [&](auto body) {
#pragma unroll 2
      for (int pass = 0; pass < 8; ++pass) {
        int row = pass * 16 + rsub;
        body(m0 + row, Cs + row * 132 + grp * 64, ROWNORM ? rsc[row] : 1.f);
      }
    });
  }
}

DI void ld8(const float* p, float (&x)[8]) { *(float4*)&x[0] = ((const float4*)p)[0]; *(float4*)&x[4] = ((const float4*)p)[1]; }
DI void st8bf(bf16_t* dst, const float (&o)[8]) {
  u32x4 v; v.x = pk2(o[0], o[1]); v.y = pk2(o[2], o[3]); v.z = pk2(o[4], o[5]); v.w = pk2(o[6], o[7]);
  *(u32x4*)dst = v;
}
DI void ep_plain(const float* p, int c8, float sc, bf16_t* dst) {
  float x[8]; ld8(p + 8 * c8, x);
#pragma unroll
  for (int j = 0; j < 8; ++j) x[j] *= sc;
  st8bf(dst + 8 * c8, x);
}
DI void ep_zero(int c8, bf16_t* dst) { u32x4 z = {0u, 0u, 0u, 0u}; *(u32x4*)(dst + 8 * c8) = z; }
template <int HALF, bool NORM>
DI void ep_head(const float* p, int base, int lc, float rs, const float* g, const float* cs, bf16_t* dst) {
  constexpr int NL = HALF / 4;
  float x[8], xp[8], o[8];
  ld8(p + base + 8 * lc, x);
  const int pl = lc ^ (NL / 2);
  ld8(p + base + 8 * pl, xp);
  float sc = rs;
  if (NORM) {
    float ss = 0.f;
#pragma unroll
    for (int j = 0; j < 8; ++j) ss += x[j] * x[j];
#pragma unroll
    for (int d = 1; d < NL; d <<= 1) ss += __shfl_xor(ss, d);
    sc = rs * rsqrtf(ss * rs * rs * (1.f / (2 * HALF)) + EPS);
  }
  const bool lo = lc < NL / 2;
  const int i0 = 8 * (lc & (NL / 2 - 1));
#pragma unroll
  for (int j = 0; j < 8; ++j) {
    float xo = x[j] * sc, xq = xp[j] * sc;
    if (g) { xo *= g[8 * lc + j]; xq *= g[8 * pl + j]; }
    if (cs) {
      float co = cs[2 * (i0 + j)], si = cs[2 * (i0 + j) + 1];
      o[j] = lo ? (xo * co - xq * si) : (xq * si + xo * co);
    } else o[j] = xo;
  }
  st8bf(dst + base + 8 * lc, o);
}
DI void ep_norm64(const float* p, int c8, float rs, const float* g, const float* cs, bf16_t* dst) { ep_head<32, true>(p, 0, c8, rs, g, cs, dst); }

template <int NCT> struct FState { f32x16 o[NCT][2]; float m[NCT]; float l[NCT]; };
template <int NCT> DI void fs_init(FState<NCT>& st) {
#pragma unroll
  for (int a = 0; a < NCT; ++a) { st.m[a] = MFLOOR; st.l[a] = 0.f;
#pragma unroll
    for (int b = 0; b < 2; ++b) st.o[a][b] = zero16(); }
}
struct KVSrc { const bf16_t* k1; long ks1; const bf16_t* k2; long ks2; const bf16_t* v; long vs; };

template <int DQ>
DI void kv_load(const KVSrc& s, int key0, int nvalid, u32x4 (&kr)[DQ / 32], u32x4 (&vr)[2], int tid) {
  constexpr int CPR = DQ / 8;
#pragma unroll
  for (int i = 0; i < DQ / 32; ++i) {
    int c = tid + 256 * i; int row = c / CPR, cc = c % CPR; int key = key0 + row;
    u32x4 z = {0u, 0u, 0u, 0u};
    if (key < nvalid) {
      const bf16_t* ptr = (cc < 8) ? s.k1 + (long)key * s.ks1 + cc * 8 : s.k2 + (long)key * s.ks2 + (cc - 8) * 8;
      z = *(const u32x4*)ptr;
    }
    kr[i] = z;
  }
#pragma unroll
  for (int i = 0; i < 2; ++i) {
    int c = tid + 256 * i; int row = c >> 3, cc = c & 7; int key = key0 + row;
    u32x4 z = {0u, 0u, 0u, 0u};
    if (key < nvalid) z = *(const u32x4*)(s.v + (long)key * s.vs + cc * 8);
    vr[i] = z;
  }
}
template <int DQ>
DI void kv_store(bf16_t* Ks, bf16_t* Vs, const u32x4 (&kr)[DQ / 32], const u32x4 (&vr)[2], int tid) {
  constexpr int CPR = DQ / 8;
#pragma unroll
  for (int i = 0; i < DQ / 32; ++i) { int c = tid + 256 * i; int row = c / CPR, cc = c % CPR; *(u32x4*)(Ks + row * (DQ + 8) + cc * 8) = kr[i]; }
#pragma unroll
  for (int i = 0; i < 2; ++i) { int c = tid + 256 * i; int row = c >> 3, cc = c & 7; *(u32x4*)(Vs + row * 72 + cc * 8) = vr[i]; }
}

template <int DQ, bool MASKED, class MaskF>
DI void score_tile(const bf16_t* Ks, const bf16x8 (&qf)[DQ / 16], f32x16 (&s)[2], MaskF mask, int r, int h) {
#pragma unroll
  for (int sub = 0; sub < 2; ++sub) {
    f32x16 acc = zero16();
#pragma unroll
    for (int ks = 0; ks < DQ / 16; ++ks) {
      bf16x8 a = *(const bf16x8*)(Ks + (sub * 32 + r) * (DQ + 8) + ks * 16 + 8 * h);
      acc = mfma32(a, qf[ks], acc);
    }
    if (MASKED) {
#pragma unroll
      for (int i = 0; i < 16; ++i) acc[i] = mask(sub, i) ? acc[i] : NEGF;
    }
    s[sub] = acc;
  }
}

template <int DQ, int NCT, bool MASKED, class MaskF>
DI void flash_tile(const bf16_t* Ks, const bf16_t* Vs, const bf16x8 (&qf)[NCT][DQ / 16], FState<NCT>& st, float sc2, MaskF mask, int lane) {
  const int r = lane & 31, h = lane >> 5;
  const int q4 = (lane & 15) >> 2, pp = lane & 3, blk = (lane >> 4) & 1;
#pragma unroll
  for (int ct = 0; ct < NCT; ++ct) {
    bf16x8 pf[4];
    {
      f32x16 s[2];
      score_tile<DQ, MASKED>(Ks, qf[ct], s, [&](int sub, int i) { return mask(ct, sub, i); }, r, h);
      float mx = NEGF;
#pragma unroll
      for (int sub = 0; sub < 2; ++sub)
#pragma unroll
        for (int i = 0; i < 16; ++i) mx = fmaxf(mx, s[sub][i]);
      mx = fmaxf(mx, __shfl_xor(mx, 32));
      float mnew = fmaxf(st.m[ct], mx * sc2);
      float alpha = ex2(st.m[ct] - mnew);
      st.m[ct] = mnew;
      float rs = 0.f;
#pragma unroll
      for (int sub = 0; sub < 2; ++sub)
#pragma unroll
        for (int i = 0; i < 16; ++i) { float pv = ex2(fmaf(s[sub][i], sc2, -mnew)); s[sub][i] = pv; rs += pv; }
      rs += __shfl_xor(rs, 32);
      st.l[ct] = st.l[ct] * alpha + rs;
      if (__ballot(alpha != 1.f) != 0ull) {
#pragma unroll
        for (int d = 0; d < 2; ++d)
#pragma unroll
          for (int i = 0; i < 16; ++i) st.o[ct][d][i] *= alpha;
      }
#pragma unroll
      for (int sub = 0; sub < 2; ++sub)
#pragma unroll
        for (int s2 = 0; s2 < 2; ++s2) pf[sub * 2 + s2] = pack8(s[sub], s2);
    }
#pragma unroll
    for (int dvt = 0; dvt < 2; ++dvt)
#pragma unroll
      for (int f = 0; f < 4; ++f) {
        int keybase = (f >> 1) * 32 + (f & 1) * 16 + 4 * h;
        const bf16_t* vp = Vs + (keybase + q4) * 72 + dvt * 32 + 16 * blk + 4 * pp;
        s16x4 lo = trread(vp), hi = trread(vp + 8 * 72);
        bf16x8 vf = __builtin_shufflevector(lo, hi, 0, 1, 2, 3, 4, 5, 6, 7);
        st.o[ct][dvt] = mfma32(vf, pf[f], st.o[ct][dvt]);
      }
  }
}

DI void write_out(const f32x16 (&o)[2], float inv, const bf16_t* gate, bf16_t* dst, int h) {
#pragma unroll
  for (int dvt = 0; dvt < 2; ++dvt)
#pragma unroll
    for (int g4 = 0; g4 < 4; ++g4) {
      int dv = dvt * 32 + 8 * g4 + 4 * h;
      uint2 gv = *(const uint2*)(gate + dv);
      float y0 = o[dvt][4 * g4] * inv * siluf(bflo(gv.x)), y1 = o[dvt][4 * g4 + 1] * inv * siluf(bfhi(gv.x));
      float y2 = o[dvt][4 * g4 + 2] * inv * siluf(bflo(gv.y)), y3 = o[dvt][4 * g4 + 3] * inv * siluf(bfhi(gv.y));
      uint2 ov; ov.x = pk2(y0, y1); ov.y = pk2(y2, y3);
      *(uint2*)(dst + dv) = ov;
    }
}

template <int DQ>
DI void load_q(bf16x8 (&qf)[DQ / 16], const bf16_t* qrow, int h) {
#pragma unroll
  for (int ks = 0; ks < DQ / 16; ++ks) qf[ks] = *(const bf16x8*)(qrow + ks * 16 + 8 * h);
}

template <int DQ, int NCT, bool DB = false, class MaskF, class NeedF>
DI void attn_pass(const KVSrc& src, int kt0, int kt1, int nvalid, const bf16x8 (&qf)[NCT][DQ / 16], FState<NCT>& st, float sc2, MaskF mask, NeedF need, char* smem) {
  const int tid = tidx(), lane = tid & 63;
  u32x4 kr[DQ / 32], vr[2];
  if (!DB) {
    bf16_t* Ks = (bf16_t*)smem; bf16_t* Vs = (bf16_t*)(smem + 13312);
    if (kt0 < kt1) kv_load<DQ>(src, kt0 * 64, nvalid, kr, vr, tid);
    for (int kt = kt0; kt < kt1; ++kt) {
      __syncthreads();
      kv_store<DQ>(Ks, Vs, kr, vr, tid);
      __syncthreads();
      if (kt + 1 < kt1) kv_load<DQ>(src, (kt + 1) * 64, nvalid, kr, vr, tid);
      const int nd = need(kt);
      if (nd == 1) flash_tile<DQ, NCT, false>(Ks, Vs, qf, st, sc2, [&](int ct, int sub, int i) { return true; }, lane);
      else if (nd == 2) flash_tile<DQ, NCT, true>(Ks, Vs, qf, st, sc2, [&](int ct, int sub, int i) { return mask(kt, ct, sub, i); }, lane);
    }
  } else {
    if (kt0 >= kt1) return;
    kv_load<DQ>(src, kt0 * 64, nvalid, kr, vr, tid);
    __syncthreads();
    kv_store<DQ>((bf16_t*)smem, (bf16_t*)(smem + 13312), kr, vr, tid);
    __syncthreads();
    int cur = 0;
    for (int kt = kt0; kt < kt1; ++kt) {
      bf16_t* Ks = (bf16_t*)(smem + cur * 22528); bf16_t* Vs = (bf16_t*)(smem + cur * 22528 + 13312);
      const bool more = kt + 1 < kt1;
      if (more) kv_load<DQ>(src, (kt + 1) * 64, nvalid, kr, vr, tid);
      const int nd = need(kt);
      if (nd == 1) flash_tile<DQ, NCT, false>(Ks, Vs, qf, st, sc2, [&](int ct, int sub, int i) { return true; }, lane);
      else if (nd == 2) flash_tile<DQ, NCT, true>(Ks, Vs, qf, st, sc2, [&](int ct, int sub, int i) { return mask(kt, ct, sub, i); }, lane);
      if (more) kv_store<DQ>((bf16_t*)(smem + (cur ^ 1) * 22528), (bf16_t*)(smem + (cur ^ 1) * 22528 + 13312), kr, vr, tid);
      __syncthreads();
      cur ^= 1;
    }
  }
}

#ifndef MLA_NCT
#define MLA_NCT 1
#endif
#ifndef MEM_NCT
#define MEM_NCT 2
#endif
#ifndef DSA_NCT
#define DSA_NCT 2
#endif
DI void mla_item(const Params& p, int item, char* smem) {
  constexpr int NCT = MLA_NCT, NQB = 32 / NCT;
  const int qb = NQB - 1 - (item >> 6), bh = item & 63, b = bh >> 3, hd = bh & 7;
  const int tid = tidx(), lane = tid & 63, w = __builtin_amdgcn_readfirstlane(tid >> 6), r = lane & 31, h = lane >> 5;
  const int q0 = qb * 128 * NCT;
  int tq[NCT]; bf16x8 qf[NCT][6];
#pragma unroll
  for (int ct = 0; ct < NCT; ++ct) { tq[ct] = q0 + (w * NCT + ct) * 32 + r; load_q<96>(qf[ct], p.qbuf + ((long)b * S_ + tq[ct]) * 768 + hd * 96, h); }
  KVSrc src; src.k1 = p.kbuf + (long)b * S_ * 512 + hd * 64; src.ks1 = 512; src.k2 = p.U + (long)b * S_ * NPE + E_AKR; src.ks2 = NPE;
  src.v = p.vbuf + (long)b * S_ * 512 + hd * 64; src.vs = 512;
  FState<NCT> st; fs_init(st);
  const int wminq = q0 + w * NCT * 32, wmaxq = wminq + NCT * 32 - 1;
  const float sc2 = 0.10206207261596575f * LOG2E;
  attn_pass<96, NCT, true>(src, 0, (q0 + 128 * NCT) / 64, S_, qf, st, sc2,
                     [&](int kt, int ct, int sub, int i) { return kt * 64 + sub * 32 + crow(i, h) <= tq[ct]; },
                     [&](int kt) { return kt * 64 > wmaxq ? 0 : (kt * 64 + 63 <= wminq ? 1 : 2); }, smem);
#pragma unroll
  for (int ct = 0; ct < NCT; ++ct) {
    const long tok = (long)b * S_ + tq[ct];
    float inv = st.l[ct] > 0.f ? 1.f / st.l[ct] : 0.f;
    write_out(st.o[ct], inv, p.U + tok * NPE + E_AGATE + hd * 64, p.mix + tok * 1280 + hd * 64, h);
  }
}

DI void mem_item(const Params& p, int layer, int item, char* smem) {
  constexpr int NCT = MEM_NCT;
  const bool odd = layer & 1; const int NP = odd ? NPO : NPE, cq = odd ? O_MQ : E_MQ, cg_ = odd ? O_MGATE : E_MGATE;
  const int qb = item >> 5, bh = item & 31, b = bh >> 2, hd = bh & 3;
  const int tid = tidx(), lane = tid & 63, w = __builtin_amdgcn_readfirstlane(tid >> 6), r = lane & 31, h = lane >> 5;
  int tq[NCT]; bf16x8 qf[NCT][4];
#pragma unroll
  for (int ct = 0; ct < NCT; ++ct) { tq[ct] = qb * 128 * NCT + (w * NCT + ct) * 32 + r; load_q<64>(qf[ct], p.U + ((long)b * S_ + tq[ct]) * NP + cq + hd * 64, h); }
  KVSrc src; src.k1 = p.memk + ((long)(layer * NB + b) * 256) * 256 + hd * 64; src.ks1 = 256; src.k2 = src.k1; src.ks2 = 0;
  src.v = p.memv + ((long)(layer * NB + b) * 256) * 256 + hd * 64; src.vs = 256;
  FState<NCT> st; fs_init(st);
  attn_pass<64, NCT, true>(src, 0, 4, 256, qf, st, 0.125f * LOG2E, [&](int, int, int, int) { return true; }, [&](int) { return 1; }, smem);
#pragma unroll
  for (int ct = 0; ct < NCT; ++ct) {
    const long tok = (long)b * S_ + tq[ct];
    float inv = st.l[ct] > 0.f ? 1.f / st.l[ct] : 0.f;
    write_out(st.o[ct], inv, p.U + tok * NP + cg_ + hd * 64, p.mix + tok * 1280 + 1024 + hd * 64, h);
  }
}

DI void dsa_item(const Params& p, int item, char* smem) {
  constexpr int NCT = DSA_NCT, NQB = 256 / NCT;
  const int qb = NQB - 1 - (item >> 3), b = item & 7;
  const int tid = tidx(), lane = tid & 63, w = __builtin_amdgcn_readfirstlane(tid >> 6), r = lane & 31, h = lane >> 5;
  const int q0 = qb * 16 * NCT;
  int tq[NCT]; bf16x8 qf[NCT][4];
  const int hd = r & 7;
  const unsigned* mwb = p.maskw + (long)b * S_ * 128;
#pragma unroll
  for (int ct = 0; ct < NCT; ++ct) {
    tq[ct] = q0 + (w * NCT + ct) * 4 + (r >> 3);
    const long tok = (long)b * S_ + tq[ct];
    load_q<64>(qf[ct], p.U + tok * NPO + O_CQ + hd * 64, h);
  }
  KVSrc src; src.k1 = p.U + (long)b * S_ * NPO + O_CK; src.ks1 = NPO; src.k2 = src.k1; src.ks2 = 0; src.v = p.U + (long)b * S_ * NPO + O_CV; src.vs = NPO;
  FState<NCT> st; fs_init(st);
  attn_pass<64, NCT, false>(src, 0, (q0 + 16 * NCT - 1) / 64 + 1, S_, qf, st, 0.125f * LOG2E,
                     [&](int kt, int ct, int sub, int i) { unsigned wd = mwb[tq[ct] * 128 + kt * 2 + sub]; return ((wd >> crow(i, h)) & 1u) != 0u; },
                     [&](int) { return 2; }, smem);
#pragma unroll
  for (int ct = 0; ct < NCT; ++ct) {
    const long tok = (long)b * S_ + tq[ct];
    float inv = st.l[ct] > 0.f ? 1.f / st.l[ct] : 0.f;
    write_out(st.o[ct], inv, p.U + tok * NPO + O_CGATE + hd * 64, p.mix + tok * 1280 + hd * 64, h);
  }
}

DI void nsa_item(const Params& p, int item, char* smem) {
  const int qb = 127 - (item >> 4), bg = item & 15, b = bg >> 1, g = bg & 1;
  const int tid = tidx(), lane = tid & 63, w = __builtin_amdgcn_readfirstlane(tid >> 6), r = lane & 31, h = lane >> 5;
  const int q0 = qb * 32, cur = q0 >> 6;
  bf16_t* Ks = (bf16_t*)smem; bf16_t* Vs = (bf16_t*)(smem + 13312);
  float* imp = (float*)(smem + 22528);
  unsigned long long* selm = (unsigned long long*)(smem + 30720);
  unsigned long long* uni = (unsigned long long*)(smem + 30976);
  const int ql = w * 8 + (r >> 2), tq = q0 + ql, hd = g * 4 + (r & 3);
  const long tok = (long)b * S_ + tq;
  bf16x8 qf[1][4];
  load_q<64>(qf[0], p.U + tok * NPE + E_BQ + hd * 64, h);
  const float sc2 = 0.125f * LOG2E;
  float* oaccL = (float*)(smem + 32768) + tid;
  const float* gatep = p.misc + tok * 32 + hd * 3;
  for (int i = tid; i < 32 * 64; i += 256) imp[i] = 0.f;

  KVSrc csrc; csrc.k1 = p.kcmp + (long)b * 256 * 128 + g * 64; csrc.ks1 = 128; csrc.k2 = csrc.k1; csrc.ks2 = 0; csrc.v = p.vcmp + (long)b * 256 * 128 + g * 64; csrc.vs = 128;
  const int nmax = q0 >> 4;
  const int nct = (nmax >> 6) + 1;
  FState<1> st; fs_init(st);
  auto cmask = [&](int kt, int sub, int i) { int n = kt * 64 + sub * 32 + crow(i, h); return 16 * n + 31 <= tq; };
  attn_pass<64, 1>(csrc, 0, nct, 255, qf, st, sc2, [&](int kt, int, int sub, int i) { return cmask(kt, sub, i); }, [&](int) { return 2; }, smem);
  const float linv = st.l[0] > 0.f ? 1.f / st.l[0] : 0.f;
  const float mfin = st.m[0];
  const float g0l = sigmf(gatep[0]) * linv;
#pragma unroll
  for (int d = 0; d < 2; ++d)
#pragma unroll
    for (int i = 0; i < 16; ++i) oaccL[(d * 16 + i) * 256] = g0l * st.o[0][d][i];
  {
    u32x4 kr[2], vr[2];
    float carry = 0.f;
    for (int kt = 0; kt < nct; ++kt) {
      __syncthreads();
      kv_load<64>(csrc, kt * 64, 255, kr, vr, tid);
      kv_store<64>(Ks, Vs, kr, vr, tid);
      __syncthreads();
      f32x16 s[2];
      score_tile<64, true>(Ks, qf[0], s, [&](int sub, int i) { return cmask(kt, sub, i); }, r, h);
#pragma unroll
      for (int sub = 0; sub < 2; ++sub) {
        float pr[16];
#pragma unroll
        for (int i = 0; i < 16; ++i) pr[i] = ex2(fmaf(s[sub][i], sc2, -mfin)) * linv;
        float part[4];
#pragma unroll
        for (int g4 = 0; g4 < 4; ++g4) part[g4] = __shfl_xor(pr[4 * g4 + 3], 32);
#pragma unroll
        for (int g4 = 0; g4 < 4; ++g4) {
          float gs = pr[4 * g4] + pr[4 * g4 + 1] + pr[4 * g4 + 2] + pr[4 * g4 + 3];
          float ex = h ? part[g4] : (g4 > 0 ? part[g4 - 1] : carry);
          float v = gs + ex;
          v += __shfl_xor(v, 1); v += __shfl_xor(v, 2);
          int j = kt * 16 + sub * 8 + 2 * g4 + h;
          if ((r & 3) == 0) imp[ql * 64 + j] = v;
        }
        carry = part[3];
      }
    }
  }
  __syncthreads();
  {
    unsigned long long wun = 0ull;
    for (int qi = 0; qi < 8; ++qi) {
      int qq = w * 8 + qi; int t = q0 + qq;
      int j = lane;
      float forced = (j == cur) ? 3e4f : ((j == cur - 1) ? 2e4f : ((j == 0) ? 1e4f : 0.f));
      float sc = (64 * j <= t) ? imp[qq * 64 + j] + forced : NEGF;
      int rank = 0;
#pragma unroll
      for (int i = 0; i < 64; ++i) {
        float si = __uint_as_float(__builtin_amdgcn_readlane(__float_as_uint(sc), i));
        rank += (si > sc || (si == sc && i < j)) ? 1 : 0;
      }
      unsigned long long m = __ballot(rank < 16 && 64 * j <= t);
      if (lane == 0) selm[qq] = m;
      wun |= m;
    }
    if (lane == 0) uni[w] = wun;
  }
  __syncthreads();
  const unsigned long long un = uni[0] | uni[1] | uni[2] | uni[3];
  const unsigned long long sm = selm[ql];
  {
    KVSrc ssrc; ssrc.k1 = p.U + (long)b * S_ * NPE + E_BKS + g * 64; ssrc.ks1 = NPE; ssrc.k2 = ssrc.k1; ssrc.ks2 = 0; ssrc.v = p.U + (long)b * S_ * NPE + E_BVS + g * 64; ssrc.vs = NPE;
    fs_init(st);
    u32x4 kr[2], vr[2];
    unsigned long long rem = un;
    int j = rem ? __builtin_ctzll(rem) : -1;
    if (j >= 0) kv_load<64>(ssrc, j * 64, S_, kr, vr, tid);
    while (j >= 0) {
      rem &= rem - 1;
      int jn = rem ? __builtin_ctzll(rem) : -1;
      __syncthreads();
      kv_store<64>(Ks, Vs, kr, vr, tid);
      __syncthreads();
      if (jn >= 0) kv_load<64>(ssrc, jn * 64, S_, kr, vr, tid);
      bool b0 = (sm >> j) & 1ull;
      if (__ballot(b0) != 0ull)
        flash_tile<64, 1, true>(Ks, Vs, qf, st, sc2, [&](int, int sub, int i) { return b0 && (j * 64 + sub * 32 + crow(i, h) <= tq); }, lane);
      j = jn;
    }
    float li = (st.l[0] > 0.f ? 1.f / st.l[0] : 0.f) * sigmf(gatep[1]);
#pragma unroll
    for (int d = 0; d < 2; ++d)
#pragma unroll
      for (int i = 0; i < 16; ++i) oaccL[(d * 16 + i) * 256] += li * st.o[0][d][i];
  }
  {
    KVSrc wsrc; wsrc.k1 = p.U + (long)b * S_ * NPE + E_BKW + g * 64; wsrc.ks1 = NPE; wsrc.k2 = wsrc.k1; wsrc.ks2 = 0; wsrc.v = p.U + (long)b * S_ * NPE + E_BVW + g * 64; wsrc.vs = NPE;
    fs_init(st);
    int kt0 = q0 - 511 < 0 ? 0 : (q0 - 511) >> 6;
    attn_pass<64, 1>(wsrc, kt0, cur + 1, S_, qf, st, sc2,
                     [&](int kt, int, int sub, int i) { int key = kt * 64 + sub * 32 + crow(i, h); return key <= tq && key > tq - 512; },
                     [&](int kt) { return (kt * 64 + 63 <= q0 + w * 8 && kt * 64 > q0 + w * 8 + 7 - 512) ? 1 : 2; }, smem);
    float li = (st.l[0] > 0.f ? 1.f / st.l[0] : 0.f) * sigmf(gatep[2]);
#pragma unroll
    for (int d = 0; d < 2; ++d)
#pragma unroll
      for (int i = 0; i < 16; ++i) st.o[0][d][i] = oaccL[(d * 16 + i) * 256] + li * st.o[0][d][i];
  }
  write_out(st.o[0], 1.f, p.U + tok * NPE + E_BGATE + hd * 64, p.mix + tok * 1280 + 512 + hd * 64, h);
  __syncthreads();
}

DI void cmp_item(const Params& p, int li, int item, char* smem) {
  const int kv = item & 1, tile = item >> 1;
  const int tid = tidx(), lane = tid & 63, w = __builtin_amdgcn_readfirstlane(tid >> 6), r = lane & 31, h = lane >> 5;
  float* part = (float*)smem;
  float* h1 = (float*)(smem + 33280);
  float* o2 = (float*)(smem + 41600);
  const int idx = tile * 32 + r;
  const bool rv = idx < NB * 255 * 2;
  const int bb = rv ? idx / 510 : 0, rem = rv ? idx % 510 : 0, n = rem >> 1, g = rem & 1;
  const bf16_t* arow = p.U + ((long)(bb * S_ + 16 * n)) * NPE + (kv ? E_BVC : E_BKC) + g * 64;
  const float* pe = p.nsa_cmp_pos + (long)(li * 2 + kv) * 32 * 64;
  const bf16_t* W1 = p.Wc1T + (long)(li * 2 + kv) * 64 * 2048;
  f32x16 acc[2] = {zero16(), zero16()};
  for (int ks_ = 0; ks_ < 32; ++ks_) {
    int ks = ks_; asm volatile("" : "+s"(ks));
    int k = w * 512 + ks * 16 + 8 * h; int l = k >> 6, d = k & 63;
    u32x4 av = *(const u32x4*)(arow + (long)l * NPE + d);
    float4 pa = *(const float4*)(pe + l * 64 + d), pb = *(const float4*)(pe + l * 64 + d + 4);
    u32x4 af;
    af.x = pk2(bflo(av.x) + pa.x, bfhi(av.x) + pa.y); af.y = pk2(bflo(av.y) + pa.z, bfhi(av.y) + pa.w);
    af.z = pk2(bflo(av.z) + pb.x, bfhi(av.z) + pb.y); af.w = pk2(bflo(av.w) + pb.z, bfhi(av.w) + pb.w);
    bf16x8 a = __builtin_bit_cast(bf16x8, af);
#pragma unroll
    for (int nt = 0; nt < 2; ++nt) {
      bf16x8 bfr = *(const bf16x8*)(W1 + (long)(nt * 32 + r) * 2048 + k);
      acc[nt] = mfma32(a, bfr, acc[nt]);
    }
  }
  __syncthreads();
#pragma unroll
  for (int nt = 0; nt < 2; ++nt)
#pragma unroll
    for (int i = 0; i < 16; ++i) part[(w * 32 + crow(i, h)) * 65 + nt * 32 + r] = acc[nt][i];
  __syncthreads();
  for (int e = tid; e < 32 * 64; e += 256) {
    int rr = e >> 6, cc = e & 63;
    float v = part[rr * 65 + cc] + part[(32 + rr) * 65 + cc] + part[(64 + rr) * 65 + cc] + part[(96 + rr) * 65 + cc];
    h1[rr * 65 + cc] = siluf(v);
  }
  __syncthreads();
  {
    const float* W2 = p.nsa_cmp_w2 + (long)(li * 2 + kv) * 64 * 64;
    int rr = tid >> 3, c0 = (tid & 7) * 8;
    float o[8] = {0.f, 0.f, 0.f, 0.f, 0.f, 0.f, 0.f, 0.f};
    for (int i = 0; i < 64; ++i) {
      float hv = h1[rr * 65 + i];
      float4 wa = *(const float4*)(W2 + i * 64 + c0), wb = *(const float4*)(W2 + i * 64 + c0 + 4);
      o[0] += hv * wa.x; o[1] += hv * wa.y; o[2] += hv * wa.z; o[3] += hv * wa.w;
      o[4] += hv * wb.x; o[5] += hv * wb.y; o[6] += hv * wb.z; o[7] += hv * wb.w;
    }
#pragma unroll
    for (int j = 0; j < 8; ++j) o2[rr * 65 + c0 + j] = o[j];
  }
  __syncthreads();
  if (tid < 32) {
    int idx2 = tile * 32 + tid;
    if (idx2 < NB * 255 * 2) {
      int b2 = idx2 / 510, rem2 = idx2 % 510, n2 = rem2 >> 1, g2 = rem2 & 1;
      const float* row = o2 + tid * 65;
      bf16_t* dst = (kv ? p.vcmp : p.kcmp) + ((long)(b2 * 256 + n2)) * 128 + g2 * 64;
      if (kv) {
#pragma unroll 4
        for (int i = 0; i < 64; ++i) dst[i] = f2bf(row[i]);
      } else {
        float ss = 0.f;
#pragma unroll 4
        for (int i = 0; i < 64; ++i) ss += row[i] * row[i];
        float sc = rsqrtf(ss * (1.f / 64.f) + EPS);
        const float* gn = p.nsa_k_g + li * 192;
        const float* cs = p.rope64 + ((long)(b2 * S_ + 16 * n2 + 31)) * 64;
#pragma unroll 2
        for (int i = 0; i < 32; ++i) {
          float x1 = row[i] * sc * gn[i], x2 = row[i + 32] * sc * gn[i + 32];
          float co = cs[2 * i], si = cs[2 * i + 1];
          dst[i] = f2bf(x1 * co - x2 * si); dst[i + 32] = f2bf(x1 * si + x2 * co);
        }
      }
    }
  }
  __syncthreads();
}

DI unsigned mono(float f) { unsigned u = __float_as_uint(f); return (u & 0x80000000u) ? ~u : (u | 0x80000000u); }
DI int red32(int v) {
  v += __builtin_amdgcn_update_dpp(0, v, 0xB1, 0xF, 0xF, true);
  v += __builtin_amdgcn_update_dpp(0, v, 0x4E, 0xF, 0xF, true);
  v += __builtin_amdgcn_update_dpp(0, v, 0x141, 0xF, 0xF, true);
  v += __builtin_amdgcn_update_dpp(0, v, 0x140, 0xF, 0xF, true);
  v += __shfl_xor(v, 16);
  return v;
}

DI void dsa_select_item(const Params& p, int item, char* smem) {
  const int idx_ = item >> 3, zk_ = idx_ >> 6, zj_ = idx_ & 63;
  const int b = item & 7, q8 = 511 - ((zk_ & 1) ? (zk_ * 64 + 63 - zj_) : idx_);
  const int tid_ = tidx();
  const int lane = tid_ & 63, w = __builtin_amdgcn_readfirstlane(tid_ >> 6);
  const int hq = lane >> 5, l16 = lane & 15, g16 = lane >> 4, bit = g16 & 1;
  const int tqa = q8 * 8 + 2 * w, tq = tqa + hq, tqb = tqa + 1;
  const long tokb = (long)b * S_;
  bf16x8 af = *(const bf16x8*)(p.U + (tokb + tqa + (l16 >> 3)) * NPO + O_CIQ + (l16 & 7) * 32 + 8 * g16);
  float iw[4];
#pragma unroll
  for (int j = 0; j < 4; ++j) iw[j] = p.misc[(tokb + tq) * 32 + bit * 4 + j] * 0.35355339059327373f;
  unsigned ku[64];
  unsigned* kl = (unsigned*)smem + w * 4096 + lane;
  const int imax = tqb >> 5;
  const char* ikb = (const char*)(p.U + tokb * NPO + O_CIK);
  const unsigned voff = (unsigned)(l16 * NPO + 8 * g16) * 2u;
  auto score = [&](int i) -> unsigned {
    const char* sb = ikb + (size_t)i * (32 * NPO * 2);
    bf16x8 b0 = *(const bf16x8*)(sb + voff);
    bf16x8 b1 = *(const bf16x8*)(sb + 16 * NPO * 2 + voff);
    f32x4 z = {0.f, 0.f, 0.f, 0.f};
    f32x4 c0 = __builtin_amdgcn_mfma_f32_16x16x32_bf16(af, b0, z, 0, 0, 0);
    f32x4 c1 = __builtin_amdgcn_mfma_f32_16x16x32_bf16(af, b1, z, 0, 0, 0);
    float sA = iw[0] * fmaxf(c0[0], 0.f) + iw[1] * fmaxf(c0[1], 0.f) + iw[2] * fmaxf(c0[2], 0.f) + iw[3] * fmaxf(c0[3], 0.f);
    float sB = iw[0] * fmaxf(c1[0], 0.f) + iw[1] * fmaxf(c1[1], 0.f) + iw[2] * fmaxf(c1[2], 0.f) + iw[3] * fmaxf(c1[3], 0.f);
    float keep = bit ? sB : sA, send = bit ? sA : sB;
    float sc = keep + __shfl_xor(send, 16);
    int key = 32 * i + (lane & 31);
    return mono(key <= tq ? sc : NEGF);
  };
#pragma unroll
  for (int c = 0; c < 8; ++c) {
    if (8 * c <= imax) {
#pragma unroll
      for (int j = 0; j < 8; ++j) ku[8 * c + j] = score(8 * c + j);
    } else {
#pragma unroll
      for (int j = 0; j < 8; ++j) ku[8 * c + j] = 0u;
    }
  }
  const int iend = imax < 64 ? 63 : (imax | 3);
  for (int i = 64; i <= iend; i += 4) {
    unsigned k0 = score(i), k1 = score(i + 1), k2 = score(i + 2), k3 = score(i + 3);
    kl[(i - 64) * 64] = k0; kl[(i - 63) * 64] = k1; kl[(i - 62) * 64] = k2; kl[(i - 61) * 64] = k3;
  }
  unsigned thr = 0u; int need = 1 << 20;
  unsigned* mw = p.maskw + (tokb + tq) * 128;
  const unsigned lowmask = (1u << (lane & 31)) - 1u;
  int run = 0;
  auto emit = [&](int i, unsigned kv) {
    bool eq = kv == thr, gt = kv > thr;
    unsigned long long bal = __ballot(eq);
    unsigned mine = hq ? (unsigned)(bal >> 32) : (unsigned)bal;
    int pre = __popc(mine & lowmask);
    bool sel = gt || (eq && (run + pre < need));
    run += __popc(mine);
    sel = sel && (32 * i + (lane & 31) <= tq);
    unsigned long long sb = __ballot(sel);
    unsigned word = hq ? (unsigned)(sb >> 32) : (unsigned)sb;
    if ((lane & 31) == 0) mw[i] = word;
  };
  if (imax < 64) {
    if (tqa >= 256) {
      bool done = false;
      for (int bt = 31; bt >= 0; --bt) {
        unsigned cand = thr | (1u << bt);
        int cnt = 0;
#pragma unroll
        for (int i = 0; i < 64; ++i) cnt += (ku[i] >= cand) ? 1 : 0;
        cnt = red32(cnt);
        if (!done) { thr = cnt >= 256 ? cand : thr; done = (cnt == 256); }
        if (__all(done)) break;
      }
      int cg = 0;
#pragma unroll
      for (int i = 0; i < 64; ++i) cg += (ku[i] > thr) ? 1 : 0;
      need = 256 - red32(cg);
    }
#pragma unroll
    for (int i = 0; i < 64; ++i) emit(i, ku[i]);
    for (int i = 64; i < 128; ++i) { if ((lane & 31) == 0) mw[i] = 0u; }
  } else {
    unsigned k2[64];
#pragma unroll
    for (int j = 0; j < 64; ++j) { unsigned v = kl[j * 64]; k2[j] = (64 + j <= iend) ? v : 0u; }
    bool done = false;
    for (int bt = 31; bt >= 0; --bt) {
      unsigned cand = thr | (1u << bt);
      int cnt = 0;
#pragma unroll
      for (int i = 0; i < 64; ++i) cnt += ((ku[i] >= cand) ? 1 : 0) + ((k2[i] >= cand) ? 1 : 0);
      cnt = red32(cnt);
      if (!done) { thr = cnt >= 256 ? cand : thr; done = (cnt == 256); }
      if (__all(done)) break;
    }
    int cg = 0;
#pragma unroll
    for (int i = 0; i < 64; ++i) cg += ((ku[i] > thr) ? 1 : 0) + ((k2[i] > thr) ? 1 : 0);
    need = 256 - red32(cg);
#pragma unroll
    for (int i = 0; i < 64; ++i) emit(i, ku[i]);
#pragma unroll
    for (int i = 0; i < 64; ++i) emit(64 + i, k2[i]);
  }
}

DI f32x16 mfmaf(float a, float b, f32x16 c) { return __builtin_amdgcn_mfma_f32_32x32x2f32(a, b, c, 0, 0, 0); }

DI void mlstm_stage(const Params& p, int li, int hd, long t0, int cidx, float* QW, float* Kl, float* Vl, bool needq, int tid, int w, int lane) {
  const float* cw = p.conv_w + (long)li * 4 * 512; const float* cb = p.conv_b + li * 512;
  const int d = lane;
#pragma unroll
  for (int which = 0; which < 2; ++which) {
    if (which == 0 && !needq) continue;
    int ch = which * 256 + hd * 64 + d;
    const bf16_t* up = p.U + t0 * NPO + (which ? O_DK : O_DQ) + hd * 64 + d;
    float w0 = cw[ch], w1 = cw[512 + ch], w2 = cw[1024 + ch], w3 = cw[1536 + ch], bias = cb[ch];
    int tl0 = w * 16;
    int s0 = cidx * 64 + tl0;
    float x0 = (s0 - 3 >= 0) ? bf2f(up[(long)(tl0 - 3) * NPO]) : 0.f;
    float x1 = (s0 - 2 >= 0) ? bf2f(up[(long)(tl0 - 2) * NPO]) : 0.f;
    float x2 = (s0 - 1 >= 0) ? bf2f(up[(long)(tl0 - 1) * NPO]) : 0.f;
    float* dstl = which ? Kl : QW;
#pragma unroll 4
    for (int i = 0; i < 16; ++i) {
      float x3 = bf2f(up[(long)(tl0 + i) * NPO]);
      float y = bias + w0 * x0 + w1 * x1 + w2 * x2 + w3 * x3;
      y = siluf(y);
      if (which) y *= 0.125f;
      dstl[(tl0 + i) * 65 + d] = y;
      x0 = x1; x1 = x2; x2 = x3;
    }
  }
#pragma unroll
  for (int i = 0; i < 4; ++i) {
    int cidx2 = tid + 256 * i; int tl = cidx2 >> 4, vc8 = (cidx2 & 15) * 8;
    u32x4 vv = *(const u32x4*)(p.U + (t0 + tl) * NPO + O_DV + hd * 128 + vc8);
    float4 a, bq;
    a.x = bflo(vv.x); a.y = bfhi(vv.x); a.z = bflo(vv.y); a.w = bfhi(vv.y);
    bq.x = bflo(vv.z); bq.y = bfhi(vv.z); bq.z = bflo(vv.w); bq.w = bfhi(vv.w);
    *(float4*)(Vl + tl * 128 + vc8) = a; *(float4*)(Vl + tl * 128 + vc8 + 4) = bq;
  }
}

DI void mlstm_x(const Params& p, int li, int item, char* smem) {
  const int c = item & 63, bh = item >> 6, b = bh >> 2, hd = bh & 3;
  const int tid = tidx(), lane = tid & 63, w = __builtin_amdgcn_readfirstlane(tid >> 6), r = lane & 31, h = lane >> 5;
  float* Kl = (float*)(smem + 16640); float* Vl = (float*)(smem + 33280); float* vws = (float*)(smem + 66048);
  const long t0 = (long)b * S_ + c * 64;
  const float ib = p.i_bias[li * 4 + hd], fb = p.f_bias[li * 4 + hd];
  mlstm_stage(p, li, hd, t0, c, nullptr, Kl, Vl, false, tid, w, lane);
  if (w == 0) {
    float ig = p.misc[(t0 + lane) * 32 + 8 + hd] + ib;
    float fp = p.misc[(t0 + lane) * 32 + 12 + hd] + fb;
    float lf = fminf(fp, 0.f) - log1pf(__expf(-fabsf(fp)));
    float bc = lf;
#pragma unroll
    for (int dlt = 1; dlt < 64; dlt <<= 1) { float t = __shfl_up(bc, dlt); if (lane >= dlt) bc += t; }
    float bL = __shfl(bc, 63);
    float g = bL - bc + ig;
    float gm = g;
#pragma unroll
    for (int dlt = 1; dlt < 64; dlt <<= 1) gm = fmaxf(gm, __shfl_xor(gm, dlt));
    vws[lane] = __expf(g - gm);
    if (lane == 0) { p.mS[(long)item * 4] = bL; p.mS[(long)item * 4 + 1] = gm; }
  }
  __syncthreads();
  f32x16 acc[2] = {zero16(), zero16()};
#pragma unroll
  for (int dt = 0; dt < 2; ++dt)
#pragma unroll 4
    for (int kk = 0; kk < 32; ++kk) {
      int s = 2 * kk + h;
      float a = Kl[s * 65 + dt * 32 + r] * vws[s];
      float bb = Vl[s * 128 + 32 * w + r];
      acc[dt] = mfmaf(a, bb, acc[dt]);
    }
  float* Ug = p.mU + (long)item * 8192 + 32 * w + r;
#pragma unroll
  for (int dt = 0; dt < 2; ++dt)
#pragma unroll
    for (int i = 0; i < 16; ++i) Ug[(dt * 32 + crow(i, h)) * 128] = acc[dt][i];
  if (w == 1) {
    float ns = 0.f;
    for (int s = 0; s < 64; ++s) ns += Kl[s * 65 + lane] * vws[s];
    p.mN[(long)item * 64 + lane] = ns;
  }
}

DI void mlstm_y(const Params& p, int item) {
  const int tid = tidx();
  const long base = (long)item * 64;
  f32x4 C[8], uc[8], un[8];
#pragma unroll
  for (int j = 0; j < 8; ++j) { C[j] = (f32x4){0.f, 0.f, 0.f, 0.f}; un[j] = C[j]; }
  float nn = 0.f, m = 0.f;
  float* Ub = p.mU + base * 8192 + tid * 32;
#pragma unroll
  for (int j = 0; j < 8; ++j) uc[j] = *(const f32x4*)(Ub + 4 * j);
  for (int c = 0; c < 64; ++c) {
    float bL = p.mS[(base + c) * 4], ml = p.mS[(base + c) * 4 + 1];
    float* Uc = Ub + (long)c * 8192;
    if (c + 1 < 64) {
#pragma unroll
      for (int j = 0; j < 8; ++j) un[j] = *(const f32x4*)(Uc + 8192 + 4 * j);
    }
    float mnew = fmaxf(bL + m, ml);
    float decay = __expf(bL + m - mnew), sc = __expf(ml - mnew);
#pragma unroll
    for (int j = 0; j < 8; ++j) { *(f32x4*)(Uc + 4 * j) = C[j]; C[j] = decay * C[j] + sc * uc[j]; uc[j] = un[j]; }
    if (tid == 0) p.mS[(base + c) * 4 + 2] = m;
    if (tid < 64) { float nu = p.mN[(base + c) * 64 + tid]; p.mN[(base + c) * 64 + tid] = nn; nn = decay * nn + sc * nu; }
    m = mnew;
  }
}

DI void mlstm_z(const Params& p, int li, int item, char* smem) {
  const int c = item & 63, bh = item >> 6, b = bh >> 2, hd = bh & 3;
  const int tid = tidx(), lane = tid & 63, w = __builtin_amdgcn_readfirstlane(tid >> 6), r = lane & 31, h = lane >> 5;
  float* QW = (float*)smem;
  float* Kl = (float*)(smem + 16640);
  float* Vl = (float*)(smem + 33280);
  float* vb = (float*)(smem + 66048);
  float* vc = vb + 64; float* vmt = vb + 128; float* va = vb + 192; float* nvec = vb + 320; float* vinv = vb + 384;
  const long t0 = (long)b * S_ + c * 64;
  const float ib = p.i_bias[li * 4 + hd], fb = p.f_bias[li * 4 + hd];
  mlstm_stage(p, li, hd, t0, c, QW, Kl, Vl, true, tid, w, lane);
  if (tid < 64) nvec[tid] = p.mN[(long)item * 64 + tid];
  if (w == 0) {
    const float mstate = p.mS[(long)item * 4 + 2];
    float ig = p.misc[(t0 + lane) * 32 + 8 + hd] + ib;
    float fp = p.misc[(t0 + lane) * 32 + 12 + hd] + fb;
    float lf = fminf(fp, 0.f) - log1pf(__expf(-fabsf(fp)));
    float bc = lf;
#pragma unroll
    for (int dlt = 1; dlt < 64; dlt <<= 1) { float t = __shfl_up(bc, dlt); if (lane >= dlt) bc += t; }
    float cc = ig - bc;
    float pm = cc;
#pragma unroll
    for (int dlt = 1; dlt < 64; dlt <<= 1) { float t = __shfl_up(pm, dlt); if (lane >= dlt) pm = fmaxf(pm, t); }
    float mt = bc + fmaxf(mstate, pm);
    float aa = __expf(bc + mstate - mt);
    vb[lane] = bc; vc[lane] = cc; vmt[lane] = mt; va[lane] = aa;
  }
  __syncthreads();
  float qn = 0.f;
  if (w == 0) { for (int d = 0; d < 64; ++d) qn += QW[lane * 65 + d] * nvec[d]; }
  f32x16 hacc[2] = {zero16(), zero16()};
  {
    const float* Cg = p.mU + (long)item * 8192 + 32 * w + r;
#pragma unroll 8
    for (int kk = 0; kk < 32; ++kk) {
      float bb = Cg[(2 * kk + h) * 128];
      float a0 = QW[r * 65 + 2 * kk + h], a1 = QW[(32 + r) * 65 + 2 * kk + h];
      hacc[0] = mfmaf(a0, bb, hacc[0]);
      hacc[1] = mfmaf(a1, bb, hacc[1]);
    }
  }
  f32x16 sacc = zero16();
  const int tt_s = w >> 1, st_s = w & 1;
#pragma unroll 4
  for (int kk = 0; kk < 32; ++kk) {
    float a = QW[(tt_s * 32 + r) * 65 + 2 * kk + h];
    float bb = Kl[(st_s * 32 + r) * 65 + 2 * kk + h];
    sacc = mfmaf(a, bb, sacc);
  }
  __syncthreads();
  {
    int s = st_s * 32 + r; float cs_ = vc[s];
#pragma unroll
    for (int i = 0; i < 16; ++i) {
      int t = tt_s * 32 + crow(i, h);
      float wv = (s <= t) ? sacc[i] * __expf(vb[t] - vmt[t] + cs_) : 0.f;
      QW[t * 65 + s] = wv;
    }
  }
  __syncthreads();
#pragma unroll
  for (int tt = 0; tt < 2; ++tt)
#pragma unroll
    for (int i = 0; i < 16; ++i) hacc[tt][i] *= va[tt * 32 + crow(i, h)];
#pragma unroll 4
  for (int kk = 0; kk < 32; ++kk) {
    float bb = Vl[(2 * kk + h) * 128 + 32 * w + r];
    float a0 = QW[r * 65 + 2 * kk + h], a1 = QW[(32 + r) * 65 + 2 * kk + h];
    hacc[0] = mfmaf(a0, bb, hacc[0]);
    hacc[1] = mfmaf(a1, bb, hacc[1]);
  }
  if (w == 0) {
    float rsum = 0.f;
    for (int s = 0; s < 64; ++s) rsum += QW[lane * 65 + s];
    float den = va[lane] * qn + rsum;
    float dn = fmaxf(fabsf(den), __expf(-vmt[lane]));
    vinv[lane] = 1.f / dn;
  }
  __syncthreads();
#pragma unroll
  for (int tt = 0; tt < 2; ++tt)
#pragma unroll
    for (int i = 0; i < 16; ++i) { int t = tt * 32 + crow(i, h); Vl[t * 128 + 32 * w + r] = hacc[tt][i] * vinv[t]; }
  __syncthreads();
  {
    int t = tid >> 2, q = tid & 3;
    const float* hr = Vl + t * 128 + q * 32;
    float ss = 0.f;
#pragma unroll
    for (int i = 0; i < 8; ++i) { float4 v = ((const float4*)hr)[i]; ss += v.x * v.x + v.y * v.y + v.z * v.z + v.w * v.w; }
    ss += __shfl_xor(ss, 1); ss += __shfl_xor(ss, 2);
    float rn = rsqrtf(ss * (1.f / 128.f) + EPS);
    const float* gn = p.h_norm_g + li * 128 + q * 32;
    const bf16_t* op = p.U + (t0 + t) * NPO + O_DO + hd * 128 + q * 32;
    const bf16_t* gp = p.U + (t0 + t) * NPO + O_DGATE + hd * 128 + q * 32;
    bf16_t* dst = p.mix + (t0 + t) * 1280 + 512 + hd * 128 + q * 32;
#pragma unroll
    for (int cch = 0; cch < 4; ++cch) {
      u32x4 ov = *(const u32x4*)(op + cch * 8), gv = *(const u32x4*)(gp + cch * 8);
      float y[8];
#pragma unroll
      for (int j = 0; j < 8; ++j) y[j] = hr[cch * 8 + j] * rn * gn[cch * 8 + j];
      y[0] *= sigmf(bflo(ov.x)) * siluf(bflo(gv.x)); y[1] *= sigmf(bfhi(ov.x)) * siluf(bfhi(gv.x));
      y[2] *= sigmf(bflo(ov.y)) * siluf(bflo(gv.y)); y[3] *= sigmf(bfhi(ov.y)) * siluf(bfhi(gv.y));
      y[4] *= sigmf(bflo(ov.z)) * siluf(bflo(gv.z)); y[5] *= sigmf(bfhi(ov.z)) * siluf(bfhi(gv.z));
      y[6] *= sigmf(bflo(ov.w)) * siluf(bflo(gv.w)); y[7] *= sigmf(bfhi(ov.w)) * siluf(bfhi(gv.w));
      u32x4 o; o.x = pk2(y[0], y[1]); o.y = pk2(y[2], y[3]); o.z = pk2(y[4], y[5]); o.w = pk2(y[6], y[7]);
      *(u32x4*)(dst + cch * 8) = o;
    }
  }
}

DI int inproj_count(int layer) { return 256 * (((layer & 1) ? NPO : NPE) / 128) + (layer == 0 ? 256 : 0); }
DI void inproj_task(const Params& p, int layer, int t, char* smem) {
  const bool odd = layer & 1; const int li = layer >> 1;
  const int NP = odd ? NPO : NPE; const int ntn = NP / 128; const int nin = 256 * ntn;
#define ROWF [&](int row, const float* v, float rs)
  if (t < nin) {
    int mt = t / ntn, nt = t % ntn;
    if (!odd) {
      gemm_tile<true>(p.xb, DM, p.WinT[layer], DM, mt * 128, nt * 128, smem, [&](int gi, int c8, auto run) {
        bf16_t* d0 = p.U + gi * 64;
        auto n64 = [&](const float* g, bool rope) {
          if (rope) run(ROWF { ep_norm64(v, c8, rs, g, p.rope64 + (long)row * 64, d0 + (long)row * NPE); });
          else run(ROWF { ep_norm64(v, c8, rs, g, nullptr, d0 + (long)row * NPE); });
        };
        if (gi == 6) {
          if (c8 < 4) run(ROWF { ep_head<16, true>(v, 0, c8, rs, p.mla_k_norm_g + li * 96 + 64, p.rope32 + (long)row * 32, d0 + (long)row * NPE); });
          else run(ROWF { ep_zero(c8, d0 + (long)row * NPE); });
        }
        else if (gi >= 15 && gi < 23) n64(p.nsa_q_g + li * 64, true);
        else if (gi == 27 || gi == 28) n64(p.nsa_k_g + li * 192 + 64, true);
        else if (gi == 31 || gi == 32) n64(p.nsa_k_g + li * 192 + 128, true);
        else if (gi >= 43 && gi < 47) n64(p.mem_q_g + layer * 64, false);
        else if (gi == 51) { if (c8 < 3) run(ROWF { float x[8]; ld8(v + 8 * c8, x);
#pragma unroll
            for (int j = 0; j < 8; ++j) p.misc[(long)row * 32 + 8 * c8 + j] = x[j] * rs; }); }
        else run(ROWF { ep_plain(v, c8, rs, d0 + (long)row * NPE); });
      });
    } else {
      gemm_tile<true>(p.xb, DM, p.WinT[layer], DM, mt * 128, nt * 128, smem, [&](int gi, int c8, auto run) {
        bf16_t* d0 = p.U + gi * 64;
        if (gi <= 8) { const float* g = (gi < 8 ? p.dsa_q_g : p.dsa_k_g) + li * 64;
          run(ROWF { ep_norm64(v, c8, rs, g, p.rope64 + (long)row * 64, d0 + (long)row * NPO); }); }
        else if (gi >= 10 && gi < 14) run(ROWF { ep_head<16, false>(v, (c8 >> 2) * 32, c8 & 3, rs, nullptr, p.rope32 + (long)row * 32, d0 + (long)row * NPO); });
        else if (gi == 14) {
          if (c8 < 4) run(ROWF { ep_head<16, false>(v, 0, c8, rs, nullptr, p.rope32 + (long)row * 32, d0 + (long)row * NPO); });
          else run(ROWF { ep_zero(c8, d0 + (long)row * NPO); });
        }
        else if (gi >= 55 && gi < 59) { const float* g = p.mem_q_g + layer * 64; run(ROWF { ep_norm64(v, c8, rs, g, nullptr, d0 + (long)row * NPO); }); }
        else if (gi == 63) { if (c8 < 2) run(ROWF { float x[8]; ld8(v + 8 * c8, x);
#pragma unroll
            for (int j = 0; j < 8; ++j) p.misc[(long)row * 32 + 8 * c8 + j] = x[j] * rs; }); }
        else run(ROWF { ep_plain(v, c8, rs, d0 + (long)row * NPO); });
      });
    }
  } else {
    int u = t - nin; int l = u >> 6, mt = (u >> 2) & 15, nt = u & 3;
    gemm_tile<true>(p.memb, DM, p.WmemT + (long)l * 512 * 1024, DM, mt * 128, nt * 128, smem, [&](int gi, int c8, auto run) {
      if (gi < 4) run(ROWF { ep_norm64(v, c8, rs, p.mem_k_g + l * 64, nullptr, p.memk + ((long)l * 2048 + row) * 256 + gi * 64); });
      else run(ROWF { ep_plain(v, c8, rs, p.memv + ((long)l * 2048 + row) * 256 + (gi - 4) * 64); });
    });
  }
}
constexpr int NPREP = 2048 + 2048 + 256;
DI void prep_task(const Params& p, int li, int t, char* smem) {
  const int ncmp = 256, nuq = 2048;
  if (t < ncmp) {
    __syncthreads();
    cmp_item(p, li, t, smem);
  } else if (t < ncmp + nuq) {
    int u0 = t - ncmp; int mt = u0 >> 3, hd = u0 & 7;
    gemm_tile<true>(p.U + E_AQL, NPE, p.WuqT + (long)li * 1024 * 256, 256, mt * 128, hd * 128, smem, [&](int gi, int c8, auto run) {
      bf16_t* d0 = p.qbuf + hd * 96;
      if ((gi & 1) == 0) run(ROWF { ep_norm64(v, c8, rs, p.mla_q_norm_g + li * 96, nullptr, d0 + (long)row * 768); });
      else if (c8 < 4) run(ROWF { ep_head<16, true>(v, 0, c8, rs, p.mla_q_norm_g + li * 96 + 64, p.rope32 + (long)row * 32, d0 + (long)row * 768 + 64); });
    });
  } else {
    int u = t - ncmp - nuq; int mt = u >> 3, hd = u & 7;
    gemm_tile<true>(p.U + E_AKVL, NPE, p.WukvT + (long)li * 1024 * 128, 128, mt * 128, hd * 128, smem, [&](int gi, int c8, auto run) {
      if ((gi & 1) == 0) run(ROWF { ep_norm64(v, c8, rs, p.mla_k_norm_g + li * 96, nullptr, p.kbuf + (long)row * 512 + hd * 64); });
      else run(ROWF { ep_plain(v, c8, rs, p.vbuf + (long)row * 512 + hd * 64); });
    });
  }
}
DI void outproj_task(const Params& p, int layer, int t, char* smem) {
  const float* xold = (layer == 0) ? p.x : p.out;
  int mt = t >> 3, nt = t & 7;
  gemm_tile<false>(p.mix, 1280, p.WoutT + (long)layer * 1024 * 1280, 1280, mt * 128, nt * 128, smem, [&](int gi, int c8, auto run) {
    run(ROWF {
      const long o = (long)row * DM + gi * 64 + 8 * c8;
      float x[8]; ld8(v + 8 * c8, x);
      float4 xa = *(const float4*)(xold + o), xb2 = *(const float4*)(xold + o + 4);
      x[0] += xa.x; x[1] += xa.y; x[2] += xa.z; x[3] += xa.w; x[4] += xb2.x; x[5] += xb2.y; x[6] += xb2.z; x[7] += xb2.w;
      *(float4*)(p.out + o) = *(float4*)&x[0]; *(float4*)(p.out + o + 4) = *(float4*)&x[4];
      st8bf(p.xb + o, x);
    });
  });
}
#undef ROWF

typedef const __attribute__((address_space(4))) Params* KParams;
DI const Params& kparams() {
  KParams kp = (KParams)__builtin_amdgcn_kernarg_segment_ptr();
  asm volatile("" : "+s"(kp));
  return *(const Params*)kp;
}
DI int snake(int k, int t0, int bid, int nb, int total) { int tr = k * nb + (nb - 1 - bid); return ((k & 1) && (k + 1) * nb <= total) ? tr : t0; }
#define XB_TMO      128
#define XB_XCNT(j)  (256  + 64 * (j))
#define XB_XSUB(j)  (1280 + 64 * (j))
#define XB_XGEN(j)  (2304 + 64 * (j))
#define XB_TOP      3328
#define XB_TOPGEN   3392
#define XCD_BAR_WORDS 3456
#define XB_SPIN_CAP (1u << 22)
#define LAS __attribute__((address_space(3)))
DI unsigned xb_ld(unsigned* p) { return __hip_atomic_load(p, __ATOMIC_RELAXED, __HIP_MEMORY_SCOPE_AGENT); }
DI unsigned xb_add(unsigned* p, unsigned v) { return __hip_atomic_fetch_add(p, v, __ATOMIC_RELAXED, __HIP_MEMORY_SCOPE_AGENT); }
DI unsigned xb_xcc_id() { return (unsigned)__builtin_amdgcn_s_getreg((3 << 11) | 20) & 0xFu; }
#define XB_SPIN(cond, bar) do { unsigned _sp = 0; while (cond) { __builtin_amdgcn_s_sleep(1); \
    if ((++_sp & 255u) == 0u) { if (xb_ld(&(bar)[XB_TMO])) break; if (_sp > XB_SPIN_CAP) { atomicAdd(&(bar)[XB_TMO], 1u); break; } } } } while (0)
struct XcdBarrier { unsigned* bar; unsigned x; volatile LAS unsigned* st; };
DI XcdBarrier xcd_barrier_post(unsigned* bar, volatile LAS unsigned* st) {
  XcdBarrier b; b.bar = bar; b.x = xb_xcc_id(); b.st = st;
  if (threadIdx.x == 0) (void)xb_add(&bar[XB_XCNT(b.x)], 1u);
  return b;
}
DI void xcd_barrier_complete(unsigned* bar, unsigned x, unsigned& nloc, unsigned& nx) {
  const unsigned G = gridDim.x * gridDim.y * gridDim.z;
  unsigned sum, cnt, mine, sp = 0u;
  for (;;) {
    sum = 0u; cnt = 0u; mine = 0u;
#pragma unroll
    for (unsigned j = 0; j < 16; ++j) { const unsigned c = xb_ld(&bar[XB_XCNT(j)]); sum += c; cnt += (c > 0u) ? 1u : 0u; mine = (j == x) ? c : mine; }
    if (sum == G) break;
    __builtin_amdgcn_s_sleep(1);
    if ((++sp & 255u) == 0u) { if (xb_ld(&bar[XB_TMO])) break; if (sp > XB_SPIN_CAP) { atomicAdd(&bar[XB_TMO], 1u); break; } }
  }
  nloc = mine > 0u ? mine : 1u; nx = cnt > 0u ? cnt : 1u;
}
DI void xcd_barrier(const XcdBarrier& b) {
  asm volatile("s_waitcnt vmcnt(0)" ::: "memory");
  __syncthreads();
  if (threadIdx.x == 0) {
    unsigned* bar = b.bar;
    __builtin_amdgcn_s_waitcnt(0);
    unsigned nloc = b.st[0], nx = b.st[1];
    if (nloc == 0u) { xcd_barrier_complete(bar, b.x, nloc, nx); b.st[0] = nloc; b.st[1] = nx; }
    const unsigned old = xb_add(&bar[XB_XSUB(b.x)], 1u);
    const unsigned gen = old / nloc;
    if (old + 1u == (gen + 1u) * nloc) {
      __builtin_amdgcn_fence(__ATOMIC_RELEASE, "agent");
      asm volatile("s_waitcnt vmcnt(0)" ::: "memory");
      const unsigned og = xb_add(&bar[XB_TOP], 1u);
      const unsigned tg = og / nx;
      if (og + 1u == (tg + 1u) * nx) xb_add(&bar[XB_TOPGEN], 1u);
      else XB_SPIN(xb_ld(&bar[XB_TOPGEN]) == tg, bar);
      __builtin_amdgcn_fence(__ATOMIC_ACQUIRE, "agent");
      xb_add(&bar[XB_XGEN(b.x)], 1u);
      asm volatile("s_waitcnt vmcnt(0)" ::: "memory");
    } else {
      XB_SPIN(xb_ld(&bar[XB_XGEN(b.x)]) == gen, bar);
      __builtin_amdgcn_fence(__ATOMIC_ACQUIRE, "agent");
      asm volatile("s_waitcnt vmcnt(0)" ::: "memory");
    }
  }
  __syncthreads();
}
#define SMEM_DECL __shared__ __attribute__((aligned(16))) char smem[SMEM_BYTES]
__global__ void __launch_bounds__(256, 2) mega(Params p_) {
  SMEM_DECL;
  cg::grid_group grid = cg::this_grid();
  const int bid = blockIdx.x, nb = gridDim.x;
  int phase = 0;
#define PSYNC() do { ++phase; XcdBarrier xb_; xb_.bar = kparams().bar; xb_.x = xb_xcc_id(); xb_.st = (volatile LAS unsigned*)(smem + 70400); xcd_barrier(xb_); if (phase >= PHASE_LIMIT) return; } while (0)
  { const Params& p = kparams(); phase0(p, bid * 256 + tidx(), nb * 256);
    if (bid == 0) for (int i = threadIdx.x; i < XCD_BAR_WORDS; i += 256) __hip_atomic_store(p.bar + i, 0u, __ATOMIC_RELAXED, __HIP_MEMORY_SCOPE_AGENT); }
  if (threadIdx.x < 4) ((volatile unsigned*)(smem + 70400))[threadIdx.x] = 0u;
  grid.sync();
  (void)xcd_barrier_post(kparams().bar, (volatile LAS unsigned*)(smem + 70400));
  for (int layer = 0; layer < 4; ++layer) {
    const bool odd = layer & 1; const int li = layer >> 1;
    { const Params& p = kparams();
      const int ntn = (odd ? NPO : NPE) / 128;
      if ((nb & 7) == 0) {
        const int xcd = bid & 7, per = nb >> 3, tot = 32 * ntn;
        for (int j = bid >> 3; j < tot; j += per) {
          int mg = j / (8 * ntn), rem = j - mg * 8 * ntn, nt = rem >> 3, mi = rem & 7;
          inproj_task(p, layer, (xcd * 32 + mg * 8 + mi) * ntn + nt, smem);
        }
      } else {
        for (int t = bid; t < 256 * ntn; t += nb) inproj_task(p, layer, t, smem);
      }
      if (layer == 0) for (int t = bid; t < 256; t += nb) inproj_task(p, layer, 256 * ntn + t, smem);
    }
    PSYNC();
    if (!odd) {
      { const Params& p = kparams(); for (int t = bid; t < NPREP; t += nb) prep_task(p, li, t, smem); }
      PSYNC();
      { const Params& p = kparams(); for (int k = 0, t0 = bid; t0 < 2048 / MLA_NCT; ++k, t0 += nb) { int t = snake(k, t0, bid, nb, 2048 / MLA_NCT); __syncthreads(); mla_item(p, t, smem); } }
      { const Params& p = kparams(); for (int k = 0, t0 = bid; t0 < 2048; ++k, t0 += nb) { int t = snake(k, t0, bid, nb, 2048); __syncthreads(); nsa_item(p, t, smem); } }
      { const Params& p = kparams(); for (int t = bid; t < 1024 / MEM_NCT; t += nb) { __syncthreads(); mem_item(p, layer, t, smem); } }
      PSYNC();
    } else {
      { const Params& p = kparams();
        for (int t = bid; t < 2048 + 4096; t += nb) {
          __syncthreads();
          if (t < 2048) mlstm_x(p, li, t, smem); else dsa_select_item(p, t - 2048, smem);
        } }
      PSYNC();
      if (bid < 32) { const Params& p = kparams(); mlstm_y(p, bid); }
      if (bid >= 32) { const Params& p = kparams(); const int nb2 = nb - 32, b2 = bid - 32;
        for (int k = 0, t0 = b2; t0 < 2048 / DSA_NCT; ++k, t0 += nb2) { int t = snake(k, t0, b2, nb2, 2048 / DSA_NCT); __syncthreads(); dsa_item(p, t, smem); } }
      { const Params& p = kparams(); for (int t = bid; t < 1024 / MEM_NCT; t += nb) { __syncthreads(); mem_item(p, layer, t, smem); } }
      PSYNC();
      { const Params& p = kparams(); for (int t = bid; t < 2048; t += nb) { __syncthreads(); mlstm_z(p, li, t, smem); } }
      PSYNC();
    }
    { const Params& p = kparams();
      if ((nb & 7) == 0) {
        const int xcd = bid & 7, per = nb >> 3;
        for (int j = bid >> 3; j < 256; j += per) {
          int mg = j >> 6, rem = j & 63, nt = rem >> 3, mi = rem & 7;
          outproj_task(p, layer, (xcd * 32 + mg * 8 + mi) * 8 + nt, smem);
        }
      } else {
        for (int t = bid; t < 2048; t += nb) outproj_task(p, layer, t, smem);
      }
    }
    if (layer < 3) PSYNC();
  }
}

extern "C" void kernel_launch(void* const* d_in, const int* in_sizes, int n_in, void* d_out, int out_size, void* d_ws, size_t ws_size,
                              hipStream_t stream) {
  Params p{};
  const float* const* fin = (const float* const*)d_in;
  p.x = fin[0]; p.mem = fin[1]; p.pos = (const int*)d_in[2];
  p.ln_g = fin[3]; p.mem_norm_g = fin[4]; p.mem_w_kv = fin[5]; p.mem_q_g = fin[6]; p.mem_k_g = fin[7]; p.w_out = fin[8];
  p.even_w_in = fin[9]; p.mla_q_lat_g = fin[10]; p.mla_kv_lat_g = fin[11]; p.mla_w_uq = fin[12]; p.mla_w_ukv = fin[13];
  p.mla_q_norm_g = fin[14]; p.mla_k_norm_g = fin[15]; p.nsa_q_g = fin[16]; p.nsa_k_g = fin[17]; p.nsa_cmp_pos = fin[18];
  p.nsa_cmp_w1 = fin[19]; p.nsa_cmp_w2 = fin[20]; p.odd_w_in = fin[21]; p.dsa_q_g = fin[22]; p.dsa_k_g = fin[23];
  p.conv_w = fin[24]; p.conv_b = fin[25]; p.i_bias = fin[26]; p.f_bias = fin[27]; p.h_norm_g = fin[28];
  p.out = (float*)d_out;
  char* ws = (char*)d_ws; size_t off = 0;
  auto take = [&](size_t bytes) { char* r = ws + off; off += (bytes + 255) & ~(size_t)255; return r; };
  const size_t MB = 1u << 20;
  char* U = take(336 * MB);
  p.U = (bf16_t*)U; p.qbuf = (bf16_t*)(U + 208 * MB); p.xb = (bf16_t*)(U + 256 * MB); p.kbuf = (bf16_t*)(U + 256 * MB); p.vbuf = (bf16_t*)(U + 288 * MB);
  p.maskw = (unsigned*)(U + 256 * MB); p.mU = (float*)(U + 272 * MB);
  p.mix = (bf16_t*)take((size_t)T_ * 1280 * 2);
  for (int l = 0; l < 4; ++l) p.WinT[l] = (bf16_t*)take((size_t)((l & 1) ? NPO : NPE) * 1024 * 2);
  p.WoutT = (bf16_t*)take((size_t)4 * 1024 * 1280 * 2);
  p.WuqT = (bf16_t*)take((size_t)2 * 1024 * 256 * 2);
  p.WukvT = (bf16_t*)take((size_t)2 * 1024 * 128 * 2);
  p.WmemT = (bf16_t*)take((size_t)4 * 512 * 1024 * 2);
  p.Wc1T = (bf16_t*)take((size_t)4 * 64 * 2048 * 2);
  p.memb = (bf16_t*)take((size_t)NB * 256 * 1024 * 2);
  p.kcmp = (bf16_t*)take((size_t)NB * 256 * 128 * 2);
  p.vcmp = (bf16_t*)take((size_t)NB * 256 * 128 * 2);
  p.memk = (bf16_t*)take((size_t)4 * 2048 * 256 * 2);
  p.memv = (bf16_t*)take((size_t)4 * 2048 * 256 * 2);
  p.rope64 = (float*)take((size_t)T_ * 64 * 4);
  p.rope32 = (float*)take((size_t)T_ * 32 * 4);
  p.misc = (float*)take((size_t)T_ * 32 * 4);
  p.mN = (float*)take((size_t)2048 * 64 * 4);
  p.mS = (float*)take((size_t)2048 * 4 * 4);
  p.bar = (unsigned*)take(XCD_BAR_WORDS * 4);
  if (off > ws_size) { fprintf(stderr, "workspace too small: need %zu have %zu\n", off, ws_size); return; }
  static int grid_blocks = 0;
  if (!grid_blocks) {
    int dev = 0, cus = 0, per_cu = 0;
    (void)hipGetDevice(&dev);
    (void)hipDeviceGetAttribute(&cus, hipDeviceAttributeMultiprocessorCount, dev);
    (void)hipOccupancyMaxActiveBlocksPerMultiprocessor(&per_cu, mega, 256, 0);
    if (per_cu > 2) per_cu = 2;
    if (per_cu < 1) per_cu = 1;
    grid_blocks = cus * per_cu;
  }
  void* args[] = {&p};
  hipError_t e = hipLaunchCooperativeKernel((void*)mega, dim3(grid_blocks), dim3(256), args, 0, stream);
  if (e != hipSuccess) fprintf(stderr, "cooperative launch failed: %s (grid %d)\n", hipGetErrorString(e), grid_blocks);
}
```

```cpp
#include <hip/hip_runtime.h>
#include <hip/hip_cooperative_groups.h>
#include <cstdio>
namespace cg = cooperative_groups;

#define DI __device__ __forceinline__
typedef unsigned short bf16_t;
typedef short bf16x8 __attribute__((ext_vector_type(8)));
typedef short s16x4 __attribute__((ext_vector_type(4)));
typedef float f32x16 __attribute__((ext_vector_type(16)));
typedef float f32x4 __attribute__((ext_vector_type(4)));
typedef float f32x2 __attribute__((ext_vector_type(2)));
typedef __bf16 bfv2 __attribute__((ext_vector_type(2)));
typedef unsigned u32x4 __attribute__((ext_vector_type(4)));

#ifndef PHASE_LIMIT
#define PHASE_LIMIT 1000
#endif

constexpr int S_ = 4096, NB = 8, T_ = NB * S_, DM = 1024;
constexpr int NPE = 3328, NPO = 4096;
constexpr float EPS = 1e-6f;
constexpr float NEGF = -1e30f;
constexpr float LOG2E = 1.4426950408889634f;
constexpr float MFLOOR = -30000.f;
constexpr int E_AQL = 0, E_AKVL = 256, E_AKR = 384, E_AGATE = 448, E_BQ = 960, E_BKC = 1472, E_BVC = 1600, E_BKS = 1728,
              E_BVS = 1856, E_BKW = 1984, E_BVW = 2112, E_BGATE = 2240, E_MQ = 2752, E_MGATE = 3008;
constexpr int O_CQ = 0, O_CK = 512, O_CV = 576, O_CIQ = 640, O_CIK = 896, O_CGATE = 960, O_DQ = 1472, O_DK = 1728, O_DV = 1984,
              O_DO = 2496, O_DGATE = 3008, O_MQ = 3520, O_MGATE = 3776;
constexpr int SMEM_BYTES = 70656;

struct Params {
  const float *x, *mem; const int* pos;
  const float *ln_g, *mem_norm_g, *mem_w_kv, *mem_q_g, *mem_k_g, *w_out, *even_w_in, *mla_q_lat_g, *mla_kv_lat_g, *mla_w_uq,
      *mla_w_ukv, *mla_q_norm_g, *mla_k_norm_g, *nsa_q_g, *nsa_k_g, *nsa_cmp_pos, *nsa_cmp_w1, *nsa_cmp_w2, *odd_w_in, *dsa_q_g,
      *dsa_k_g, *conv_w, *conv_b, *i_bias, *f_bias, *h_norm_g;
  float* out;
  bf16_t *WinT[4], *WoutT, *WuqT, *WukvT, *WmemT, *Wc1T, *memb, *U, *xb, *qbuf, *kbuf, *vbuf, *mix, *kcmp, *vcmp, *memk, *memv;
  unsigned* maskw;
  float *rope64, *rope32, *misc, *mU, *mN, *mS;
  unsigned* bar;
};

DI int tidx() { int t = threadIdx.x; asm volatile("" : "+v"(t)); return t; }
DI float bf2f(bf16_t v) { return __uint_as_float(((unsigned)v) << 16); }
DI unsigned pk2(float a, float b) { f32x2 v = {a, b}; bfv2 r = __builtin_convertvector(v, bfv2); return __builtin_bit_cast(unsigned, r); }
DI bf16_t f2bf(float a) { return (bf16_t)(pk2(a, 0.f) & 0xffffu); }
DI float bflo(unsigned u) { return __uint_as_float(u << 16); }
DI float bfhi(unsigned u) { return __uint_as_float(u & 0xffff0000u); }
DI int crow(int i, int h) { return (i & 3) + 8 * (i >> 2) + 4 * h; }
DI float siluf(float x) { return x / (1.f + __expf(-x)); }
DI float sigmf(float x) { return 1.f / (1.f + __expf(-x)); }
DI float ex2(float x) { return __builtin_amdgcn_exp2f(x); }
DI f32x16 mfma32(bf16x8 a, bf16x8 b, f32x16 c) { return __builtin_amdgcn_mfma_f32_32x32x16_bf16(a, b, c, 0, 0, 0); }
typedef unsigned u32x2_ __attribute__((ext_vector_type(2)));
DI float xhalf_max(float x) { u32x2_ r = __builtin_amdgcn_permlane32_swap(__float_as_uint(x), __float_as_uint(x), false, false); return fmaxf(__uint_as_float(r[0]), __uint_as_float(r[1])); }
DI float xhalf_sum(float x) { u32x2_ r = __builtin_amdgcn_permlane32_swap(__float_as_uint(x), __float_as_uint(x), false, false); return __uint_as_float(r[0]) + __uint_as_float(r[1]); }
DI f32x16 zero16() { f32x16 z;
#pragma unroll
  for (int i = 0; i < 16; ++i) z[i] = 0.f; return z; }
DI bf16x8 pack8(const f32x16& x, int s) {
  u32x4 p; p.x = pk2(x[8 * s], x[8 * s + 1]); p.y = pk2(x[8 * s + 2], x[8 * s + 3]); p.z = pk2(x[8 * s + 4], x[8 * s + 5]); p.w = pk2(x[8 * s + 6], x[8 * s + 7]);
  return __builtin_bit_cast(bf16x8, p);
}
DI s16x4 trread(const bf16_t* p) {
  return __builtin_amdgcn_ds_read_tr16_b64_v4i16((s16x4 __attribute__((address_space(3)))*)(p));
}

DI int map_even(int n) { if (n < 416) return n; if (n < 448) return -1; if (n < 2240) return n - 32; if (n < 3264) return n - 8; if (n < 3288) return 2208 + (n - 3264); return -1; }
DI int map_odd(int n) { if (n < 928) return n; if (n < 960) return -1; if (n < 2496) return n - 24; if (n < 4032) return n - 16; if (n < 4040) return 928 + (n - 4032); if (n < 4048) return 2472 + (n - 4040); return -1; }
DI int map_uq(int n) { int h = n >> 7, c = n & 127; return c < 96 ? h * 96 + c : -1; }

template <int MAP>
DI void convT(bf16_t* dst, const float* src, const float* gain, int K, int Nsrc, int Npad, int gtid, int gsz) {
  int total = Npad * (K / 8);
  for (int i = gtid; i < total; i += gsz) {
    int n = (int)(i % Npad); int k0 = (int)(i / Npad) * 8;
    int sc = MAP == 0 ? n : MAP == 1 ? map_even(n) : MAP == 2 ? map_odd(n) : map_uq(n);
    u32x4 o = {0u, 0u, 0u, 0u};
    if (sc >= 0) {
      float v[8];
#pragma unroll
      for (int j = 0; j < 8; ++j) v[j] = src[(long)(k0 + j) * Nsrc + sc] * (gain ? gain[k0 + j] : 1.f);
      o.x = pk2(v[0], v[1]); o.y = pk2(v[2], v[3]); o.z = pk2(v[4], v[5]); o.w = pk2(v[6], v[7]);
    }
    *(u32x4*)(dst + (long)n * K + k0) = o;
  }
}

DI void cvt_rows(bf16_t* dst, const float* src, int n8, int gtid, int gsz) {
  for (int i = gtid; i < n8; i += gsz) {
    float4 a = ((const float4*)src)[2 * i], b = ((const float4*)src)[2 * i + 1];
    u32x4 o; o.x = pk2(a.x, a.y); o.y = pk2(a.z, a.w); o.z = pk2(b.x, b.y); o.w = pk2(b.z, b.w);
    ((u32x4*)dst)[i] = o;
  }
}

DI void phase0(const Params& p, int gtid, int gsz) {
  for (int l = 0; l < 4; ++l) {
    int li = l >> 1;
    if ((l & 1) == 0) convT<1>(p.WinT[l], p.even_w_in + (long)li * DM * 3256, p.ln_g + l * DM, DM, 3256, NPE, gtid, gsz);
    else convT<2>(p.WinT[l], p.odd_w_in + (long)li * DM * 4016, p.ln_g + l * DM, DM, 4016, NPO, gtid, gsz);
    convT<0>(p.WoutT + (long)l * 1024 * 1280, p.w_out + (long)l * 1280 * 1024, nullptr, 1280, 1024, 1024, gtid, gsz);
    convT<0>(p.WmemT + (long)l * 512 * 1024, p.mem_w_kv + (long)l * 1024 * 512, p.mem_norm_g + l * DM, 1024, 512, 512, gtid, gsz);
  }
  for (int li = 0; li < 2; ++li) {
    convT<3>(p.WuqT + (long)li * 1024 * 256, p.mla_w_uq + (long)li * 256 * 768, p.mla_q_lat_g + li * 256, 256, 768, 1024, gtid, gsz);
    convT<0>(p.WukvT + (long)li * 1024 * 128, p.mla_w_ukv + (long)li * 128 * 1024, p.mla_kv_lat_g + li * 128, 128, 1024, 1024, gtid, gsz);
    for (int kv = 0; kv < 2; ++kv)
      convT<0>(p.Wc1T + (long)(li * 2 + kv) * 64 * 2048, p.nsa_cmp_w1 + (long)(li * 2 + kv) * 2048 * 64, nullptr, 2048, 64, 64, gtid, gsz);
  }
  cvt_rows(p.xb, p.x, T_ * DM / 8, gtid, gsz);
  cvt_rows(p.memb, p.mem, NB * 256 * DM / 8, gtid, gsz);
  for (int i = gtid; i < T_ * 32; i += gsz) {
    int tok = (int)(i >> 5), f = (int)(i & 31);
    float ps = (float)p.pos[tok];
    float inv = powf(10000.f, -(float)f / 32.f);
    float ang = ps * inv;
    p.rope64[(long)i * 2] = cosf(ang); p.rope64[(long)i * 2 + 1] = sinf(ang);
    if (f < 16) {
      float inv2 = powf(10000.f, -(float)f / 16.f);
      float a2 = ps * inv2;
      p.rope32[((long)tok * 16 + f) * 2] = cosf(a2); p.rope32[((long)tok * 16 + f) * 2 + 1] = sinf(a2);
    }
  }
}

DI float sumsq8(u32x4 v) {
  float s = 0.f, t;
  t = bflo(v.x); s += t * t; t = bfhi(v.x); s += t * t; t = bflo(v.y); s += t * t; t = bfhi(v.y); s += t * t;
  t = bflo(v.z); s += t * t; t = bfhi(v.z); s += t * t; t = bflo(v.w); s += t * t; t = bfhi(v.w); s += t * t;
  return s;
}

template <bool ROWNORM, class Epi>
DI void gemm_tile(const bf16_t* __restrict__ A, int lda, const bf16_t* __restrict__ BT, int K, int m0, int n0, char* smem, Epi epi) {
  bf16_t* As = (bf16_t*)smem; bf16_t* Bs = As + 128 * 136;
  float* Cs = (float*)smem; float* rsc = (float*)(smem + 69632);
  const int tid = tidx(), lane = tid & 63, w = __builtin_amdgcn_readfirstlane(tid >> 6), wm = w >> 1, wn = w & 1, r = lane & 31, h = lane >> 5;
  const int lrow = tid >> 4, lkc = tid & 15;
  f32x16 acc[2][2];
#pragma unroll
  for (int i = 0; i < 2; ++i)
#pragma unroll
    for (int j = 0; j < 2; ++j) acc[i][j] = zero16();
  u32x4 ra[8], rb[8]; float ss[8] = {0.f, 0.f, 0.f, 0.f, 0.f, 0.f, 0.f, 0.f};
  const bf16_t* Ap = A + (long)(m0 + lrow) * lda + lkc * 8;
  const bf16_t* Bp = BT + (long)(n0 + lrow) * K + lkc * 8;
#pragma unroll
  for (int i = 0; i < 8; ++i) { ra[i] = *(const u32x4*)(Ap + (long)16 * i * lda); rb[i] = *(const u32x4*)(Bp + (long)16 * i * K); }
  const int nk = K >> 7;
  for (int kt = 0; kt < nk; ++kt) {
    __syncthreads();
#pragma unroll
    for (int i = 0; i < 8; ++i) {
      *(u32x4*)(As + (lrow + 16 * i) * 136 + lkc * 8) = ra[i];
      *(u32x4*)(Bs + (lrow + 16 * i) * 136 + lkc * 8) = rb[i];
      if (ROWNORM) ss[i] += sumsq8(ra[i]);
    }
    __syncthreads();
    if (kt + 1 < nk) {
#pragma unroll
      for (int i = 0; i < 8; ++i) { ra[i] = *(const u32x4*)(Ap + (long)16 * i * lda + (kt + 1) * 128); rb[i] = *(const u32x4*)(Bp + (long)16 * i * K + (kt + 1) * 128); }
    }
    {
      const bf16_t* Ar = As + (wm * 64 + r) * 136 + 8 * h;
      const bf16_t* Br = Bs + (wn * 64 + r) * 136 + 8 * h;
      bf16x8 fa[2][2], fb[2][2];
#pragma unroll
      for (int i = 0; i < 2; ++i) { fa[0][i] = *(const bf16x8*)(Ar + i * 32 * 136); fb[0][i] = *(const bf16x8*)(Br + i * 32 * 136); }
#pragma unroll
      for (int ks = 0; ks < 8; ++ks) {
        const int cu = ks & 1, nx = cu ^ 1;
        if (ks + 1 < 8) {
#pragma unroll
          for (int i = 0; i < 2; ++i) { fa[nx][i] = *(const bf16x8*)(Ar + i * 32 * 136 + (ks + 1) * 16); fb[nx][i] = *(const bf16x8*)(Br + i * 32 * 136 + (ks + 1) * 16); }
        }
#pragma unroll
        for (int i = 0; i < 2; ++i)
#pragma unroll
          for (int j = 0; j < 2; ++j) acc[i][j] = mfma32(fa[cu][i], fb[cu][j], acc[i][j]);
      }
    }
  }
  __syncthreads();
#pragma unroll
  for (int mi = 0; mi < 2; ++mi)
#pragma unroll
    for (int ni = 0; ni < 2; ++ni)
#pragma unroll
      for (int i = 0; i < 16; ++i) Cs[(wm * 64 + mi * 32 + crow(i, h)) * 132 + wn * 64 + ni * 32 + r] = acc[mi][ni][i];
  if (ROWNORM) {
#pragma unroll
    for (int i = 0; i < 8; ++i) {
      float sv = ss[i];
      sv += __shfl_xor(sv, 1); sv += __shfl_xor(sv, 2); sv += __shfl_xor(sv, 4); sv += __shfl_xor(sv, 8);
      if (lkc == 0) rsc[lrow + 16 * i] = rsqrtf(sv / (float)K + EPS);
    }
  }
  __syncthreads();
  {
    const int c8 = tid & 7, grp = (tid >> 3) & 1, rsub = tid >> 4;
    epi((n0 >> 6) + grp, c8, [&](auto body) {
#pragma unroll 2
      for (int pass = 0; pass < 8; ++pass) {
        int row = pass * 16 + rsub;
        body(m0 + row, Cs + row * 132 + grp * 64, ROWNORM ? rsc[row] : 1.f);
      }
    });
  }
}

DI void ld8(const float* p, float (&x)[8]) { *(float4*)&x[0] = ((const float4*)p)[0]; *(float4*)&x[4] = ((const float4*)p)[1]; }
DI void st8bf(bf16_t* dst, const float (&o)[8]) {
  u32x4 v; v.x = pk2(o[0], o[1]); v.y = pk2(o[2], o[3]); v.z = pk2(o[4], o[5]); v.w = pk2(o[6], o[7]);
  *(u32x4*)dst = v;
}
DI void ep_plain(const float* p, int c8, float sc, bf16_t* dst) {
  float x[8]; ld8(p + 8 * c8, x);
#pragma unroll
  for (int j = 0; j < 8; ++j) x[j] *= sc;
  st8bf(dst + 8 * c8, x);
}
DI void ep_zero(int c8, bf16_t* dst) { u32x4 z = {0u, 0u, 0u, 0u}; *(u32x4*)(dst + 8 * c8) = z; }
template <int HALF, bool NORM>
DI void ep_head(const float* p, int base, int lc, float rs, const float* g, const float* cs, bf16_t* dst) {
  constexpr int NL = HALF / 4;
  float x[8], xp[8], o[8];
  ld8(p + base + 8 * lc, x);
  const int pl = lc ^ (NL / 2);
  ld8(p + base + 8 * pl, xp);
  float sc = rs;
  if (NORM) {
    float ss = 0.f;
#pragma unroll
    for (int j = 0; j < 8; ++j) ss += x[j] * x[j];
#pragma unroll
    for (int d = 1; d < NL; d <<= 1) ss += __shfl_xor(ss, d);
    sc = rs * rsqrtf(ss * rs * rs * (1.f / (2 * HALF)) + EPS);
  }
  const bool lo = lc < NL / 2;
  const int i0 = 8 * (lc & (NL / 2 - 1));
#pragma unroll
  for (int j = 0; j < 8; ++j) {
    float xo = x[j] * sc, xq = xp[j] * sc;
    if (g) { xo *= g[8 * lc + j]; xq *= g[8 * pl + j]; }
    if (cs) {
      float co = cs[2 * (i0 + j)], si = cs[2 * (i0 + j) + 1];
      o[j] = lo ? (xo * co - xq * si) : (xq * si + xo * co);
    } else o[j] = xo;
  }
  st8bf(dst + base + 8 * lc, o);
}
DI void ep_norm64(const float* p, int c8, float rs, const float* g, const float* cs, bf16_t* dst) { ep_head<32, true>(p, 0, c8, rs, g, cs, dst); }

template <int NCT> struct FState { f32x16 o[NCT][2]; float m[NCT]; float l[NCT]; };
template <int NCT> DI void fs_init(FState<NCT>& st) {
#pragma unroll
  for (int a = 0; a < NCT; ++a) { st.m[a] = MFLOOR; st.l[a] = 0.f;
#pragma unroll
    for (int b = 0; b < 2; ++b) st.o[a][b] = zero16(); }
}
struct KVSrc { const bf16_t* k1; long ks1; const bf16_t* k2; long ks2; const bf16_t* v; long vs; };

template <int DQ>
DI void kv_load(const KVSrc& s, int key0, int nvalid, u32x4 (&kr)[DQ / 32], u32x4 (&vr)[2], int tid) {
  constexpr int CPR = DQ / 8;
#pragma unroll
  for (int i = 0; i < DQ / 32; ++i) {
    int c = tid + 256 * i; int row = c / CPR, cc = c % CPR; int key = key0 + row;
    u32x4 z = {0u, 0u, 0u, 0u};
    if (key < nvalid) {
      const bf16_t* ptr = (cc < 8) ? s.k1 + (long)key * s.ks1 + cc * 8 : s.k2 + (long)key * s.ks2 + (cc - 8) * 8;
      z = *(const u32x4*)ptr;
    }
    kr[i] = z;
  }
#pragma unroll
  for (int i = 0; i < 2; ++i) {
    int c = tid + 256 * i; int row = c >> 3, cc = c & 7; int key = key0 + row;
    u32x4 z = {0u, 0u, 0u, 0u};
    if (key < nvalid) z = *(const u32x4*)(s.v + (long)key * s.vs + cc * 8);
    vr[i] = z;
  }
}
template <int DQ>
DI void kv_store(bf16_t* Ks, bf16_t* Vs, const u32x4 (&kr)[DQ / 32], const u32x4 (&vr)[2], int tid) {
  constexpr int CPR = DQ / 8;
#pragma unroll
  for (int i = 0; i < DQ / 32; ++i) { int c = tid + 256 * i; int row = c / CPR, cc = c % CPR; *(u32x4*)(Ks + row * (DQ + 8) + cc * 8) = kr[i]; }
#pragma unroll
  for (int i = 0; i < 2; ++i) { int c = tid + 256 * i; int row = c >> 3, cc = c & 7; *(u32x4*)(Vs + row * 72 + cc * 8) = vr[i]; }
}

template <int DQ, bool MASKED, class MaskF>
DI void score_tile(const bf16_t* Ks, const bf16x8 (&qf)[DQ / 16], f32x16 (&s)[2], MaskF mask, int r, int h) {
#pragma unroll
  for (int sub = 0; sub < 2; ++sub) {
    f32x16 acc = zero16();
#pragma unroll
    for (int ks = 0; ks < DQ / 16; ++ks) {
      bf16x8 a = *(const bf16x8*)(Ks + (sub * 32 + r) * (DQ + 8) + ks * 16 + 8 * h);
      acc = mfma32(a, qf[ks], acc);
    }
    if (MASKED) {
#pragma unroll
      for (int i = 0; i < 16; ++i) acc[i] = mask(sub, i) ? acc[i] : NEGF;
    }
    s[sub] = acc;
  }
}

template <int DQ, int NCT, bool MASKED, class MaskF>
DI void flash_tile(const bf16_t* Ks, const bf16_t* Vs, const bf16x8 (&qf)[NCT][DQ / 16], FState<NCT>& st, float sc2, MaskF mask, int lane) {
  const int r = lane & 31, h = lane >> 5;
  const int q4 = (lane & 15) >> 2, pp = lane & 3, blk = (lane >> 4) & 1;
#pragma unroll
  for (int ct = 0; ct < NCT; ++ct) {
    bf16x8 pf[4];
    {
      f32x16 s[2];
      score_tile<DQ, MASKED>(Ks, qf[ct], s, [&](int sub, int i) { return mask(ct, sub, i); }, r, h);
      float mx = NEGF;
#pragma unroll
      for (int sub = 0; sub < 2; ++sub)
#pragma unroll
        for (int i = 0; i < 16; ++i) mx = fmaxf(mx, s[sub][i]);
      mx = xhalf_max(mx);
      float mnew = fmaxf(st.m[ct], mx * sc2);
      float alpha = ex2(st.m[ct] - mnew);
      st.m[ct] = mnew;
      float rs = 0.f;
#pragma unroll
      for (int sub = 0; sub < 2; ++sub)
#pragma unroll
        for (int i = 0; i < 16; ++i) { float pv = ex2(fmaf(s[sub][i], sc2, -mnew)); s[sub][i] = pv; rs += pv; }
      rs = xhalf_sum(rs);
      st.l[ct] = st.l[ct] * alpha + rs;
      if (__ballot(alpha != 1.f) != 0ull) {
#pragma unroll
        for (int d = 0; d < 2; ++d)
#pragma unroll
          for (int i = 0; i < 16; ++i) st.o[ct][d][i] *= alpha;
      }
#pragma unroll
      for (int sub = 0; sub < 2; ++sub)
#pragma unroll
        for (int s2 = 0; s2 < 2; ++s2) pf[sub * 2 + s2] = pack8(s[sub], s2);
    }
#pragma unroll
    for (int dvt = 0; dvt < 2; ++dvt)
#pragma unroll
      for (int f = 0; f < 4; ++f) {
        int keybase = (f >> 1) * 32 + (f & 1) * 16 + 4 * h;
        const bf16_t* vp = Vs + (keybase + q4) * 72 + dvt * 32 + 16 * blk + 4 * pp;
        s16x4 lo = trread(vp), hi = trread(vp + 8 * 72);
        bf16x8 vf = __builtin_shufflevector(lo, hi, 0, 1, 2, 3, 4, 5, 6, 7);
        st.o[ct][dvt] = mfma32(vf, pf[f], st.o[ct][dvt]);
      }
  }
}

DI void write_out(const f32x16 (&o)[2], float inv, const bf16_t* gate, bf16_t* dst, int h) {
#pragma unroll
  for (int dvt = 0; dvt < 2; ++dvt)
#pragma unroll
    for (int g4 = 0; g4 < 4; ++g4) {
      int dv = dvt * 32 + 8 * g4 + 4 * h;
      uint2 gv = *(const uint2*)(gate + dv);
      float y0 = o[dvt][4 * g4] * inv * siluf(bflo(gv.x)), y1 = o[dvt][4 * g4 + 1] * inv * siluf(bfhi(gv.x));
      float y2 = o[dvt][4 * g4 + 2] * inv * siluf(bflo(gv.y)), y3 = o[dvt][4 * g4 + 3] * inv * siluf(bfhi(gv.y));
      uint2 ov; ov.x = pk2(y0, y1); ov.y = pk2(y2, y3);
      *(uint2*)(dst + dv) = ov;
    }
}

template <int DQ>
DI void load_q(bf16x8 (&qf)[DQ / 16], const bf16_t* qrow, int h) {
#pragma unroll
  for (int ks = 0; ks < DQ / 16; ++ks) qf[ks] = *(const bf16x8*)(qrow + ks * 16 + 8 * h);
}

template <int DQ, int NCT, bool DB = false, class MaskF, class NeedF>
DI void attn_pass(const KVSrc& src, int kt0, int kt1, int nvalid, const bf16x8 (&qf)[NCT][DQ / 16], FState<NCT>& st, float sc2, MaskF mask, NeedF need, char* smem) {
  const int tid = tidx(), lane = tid & 63;
  u32x4 kr[DQ / 32], vr[2];
  if (!DB) {
    bf16_t* Ks = (bf16_t*)smem; bf16_t* Vs = (bf16_t*)(smem + 13312);
    if (kt0 < kt1) kv_load<DQ>(src, kt0 * 64, nvalid, kr, vr, tid);
    for (int kt = kt0; kt < kt1; ++kt) {
      __syncthreads();
      kv_store<DQ>(Ks, Vs, kr, vr, tid);
      __syncthreads();
      if (kt + 1 < kt1) kv_load<DQ>(src, (kt + 1) * 64, nvalid, kr, vr, tid);
      const int nd = need(kt);
      if (nd == 1) flash_tile<DQ, NCT, false>(Ks, Vs, qf, st, sc2, [&](int ct, int sub, int i) { return true; }, lane);
      else if (nd == 2) flash_tile<DQ, NCT, true>(Ks, Vs, qf, st, sc2, [&](int ct, int sub, int i) { return mask(kt, ct, sub, i); }, lane);
    }
  } else {
    if (kt0 >= kt1) return;
    kv_load<DQ>(src, kt0 * 64, nvalid, kr, vr, tid);
    __syncthreads();
    kv_store<DQ>((bf16_t*)smem, (bf16_t*)(smem + 13312), kr, vr, tid);
    __syncthreads();
    int cur = 0;
    for (int kt = kt0; kt < kt1; ++kt) {
      bf16_t* Ks = (bf16_t*)(smem + cur * 22528); bf16_t* Vs = (bf16_t*)(smem + cur * 22528 + 13312);
      const bool more = kt + 1 < kt1;
      if (more) kv_load<DQ>(src, (kt + 1) * 64, nvalid, kr, vr, tid);
      const int nd = need(kt);
      if (nd == 1) flash_tile<DQ, NCT, false>(Ks, Vs, qf, st, sc2, [&](int ct, int sub, int i) { return true; }, lane);
      else if (nd == 2) flash_tile<DQ, NCT, true>(Ks, Vs, qf, st, sc2, [&](int ct, int sub, int i) { return mask(kt, ct, sub, i); }, lane);
      if (more) kv_store<DQ>((bf16_t*)(smem + (cur ^ 1) * 22528), (bf16_t*)(smem + (cur ^ 1) * 22528 + 13312), kr, vr, tid);
      __syncthreads();
      cur ^= 1;
    }
  }
}

#ifndef MLA_NCT
#define MLA_NCT 1
#endif
#ifndef MEM_NCT
#define MEM_NCT 2
#endif
#ifndef DSA_NCT
#define DSA_NCT 2
#endif
DI void mla_item(const Params& p, int item, char* smem) {
  constexpr int NCT = MLA_NCT, NQB = 32 / NCT;
  const int qb = NQB - 1 - (item >> 6), bh = item & 63, b = bh >> 3, hd = bh & 7;
  const int tid = tidx(), lane = tid & 63, w = __builtin_amdgcn_readfirstlane(tid >> 6), r = lane & 31, h = lane >> 5;
  const int q0 = qb * 128 * NCT;
  int tq[NCT]; bf16x8 qf[NCT][6];
#pragma unroll
  for (int ct = 0; ct < NCT; ++ct) { tq[ct] = q0 + (w * NCT + ct) * 32 + r; load_q<96>(qf[ct], p.qbuf + ((long)b * S_ + tq[ct]) * 768 + hd * 96, h); }
  KVSrc src; src.k1 = p.kbuf + (long)b * S_ * 512 + hd * 64; src.ks1 = 512; src.k2 = p.U + (long)b * S_ * NPE + E_AKR; src.ks2 = NPE;
  src.v = p.vbuf + (long)b * S_ * 512 + hd * 64; src.vs = 512;
  FState<NCT> st; fs_init(st);
  const int wminq = q0 + w * NCT * 32, wmaxq = wminq + NCT * 32 - 1;
  const float sc2 = 0.10206207261596575f * LOG2E;
  attn_pass<96, NCT, true>(src, 0, (q0 + 128 * NCT) / 64, S_, qf, st, sc2,
                     [&](int kt, int ct, int sub, int i) { return kt * 64 + sub * 32 + crow(i, h) <= tq[ct]; },
                     [&](int kt) { return kt * 64 > wmaxq ? 0 : (kt * 64 + 63 <= wminq ? 1 : 2); }, smem);
#pragma unroll
  for (int ct = 0; ct < NCT; ++ct) {
    const long tok = (long)b * S_ + tq[ct];
    float inv = st.l[ct] > 0.f ? 1.f / st.l[ct] : 0.f;
    write_out(st.o[ct], inv, p.U + tok * NPE + E_AGATE + hd * 64, p.mix + tok * 1280 + hd * 64, h);
  }
}

DI void mem_item(const Params& p, int layer, int item, char* smem) {
  constexpr int NCT = MEM_NCT;
  const bool odd = layer & 1; const int NP = odd ? NPO : NPE, cq = odd ? O_MQ : E_MQ, cg_ = odd ? O_MGATE : E_MGATE;
  const int qb = item >> 5, bh = item & 31, b = bh >> 2, hd = bh & 3;
  const int tid = tidx(), lane = tid & 63, w = __builtin_amdgcn_readfirstlane(tid >> 6), r = lane & 31, h = lane >> 5;
  int tq[NCT]; bf16x8 qf[NCT][4];
#pragma unroll
  for (int ct = 0; ct < NCT; ++ct) { tq[ct] = qb * 128 * NCT + (w * NCT + ct) * 32 + r; load_q<64>(qf[ct], p.U + ((long)b * S_ + tq[ct]) * NP + cq + hd * 64, h); }
  KVSrc src; src.k1 = p.memk + ((long)(layer * NB + b) * 256) * 256 + hd * 64; src.ks1 = 256; src.k2 = src.k1; src.ks2 = 0;
  src.v = p.memv + ((long)(layer * NB + b) * 256) * 256 + hd * 64; src.vs = 256;
  FState<NCT> st; fs_init(st);
  attn_pass<64, NCT, true>(src, 0, 4, 256, qf, st, 0.125f * LOG2E, [&](int, int, int, int) { return true; }, [&](int) { return 1; }, smem);
#pragma unroll
  for (int ct = 0; ct < NCT; ++ct) {
    const long tok = (long)b * S_ + tq[ct];
    float inv = st.l[ct] > 0.f ? 1.f / st.l[ct] : 0.f;
    write_out(st.o[ct], inv, p.U + tok * NP + cg_ + hd * 64, p.mix + tok * 1280 + 1024 + hd * 64, h);
  }
}

DI void dsa_item(const Params& p, int item, char* smem) {
  constexpr int NCT = DSA_NCT, NQB = 256 / NCT;
  const int qb = NQB - 1 - (item >> 3), b = item & 7;
  const int tid = tidx(), lane = tid & 63, w = __builtin_amdgcn_readfirstlane(tid >> 6), r = lane & 31, h = lane >> 5;
  const int q0 = qb * 16 * NCT;
  int tq[NCT]; bf16x8 qf[NCT][4];
  const int hd = r & 7;
  const unsigned* mwb = p.maskw + (long)b * S_ * 128;
#pragma unroll
  for (int ct = 0; ct < NCT; ++ct) {
    tq[ct] = q0 + (w * NCT + ct) * 4 + (r >> 3);
    const long tok = (long)b * S_ + tq[ct];
    load_q<64>(qf[ct], p.U + tok * NPO + O_CQ + hd * 64, h);
  }
  KVSrc src; src.k1 = p.U + (long)b * S_ * NPO + O_CK; src.ks1 = NPO; src.k2 = src.k1; src.ks2 = 0; src.v = p.U + (long)b * S_ * NPO + O_CV; src.vs = NPO;
  FState<NCT> st; fs_init(st);
  attn_pass<64, NCT, false>(src, 0, (q0 + 16 * NCT - 1) / 64 + 1, S_, qf, st, 0.125f * LOG2E,
                     [&](int kt, int ct, int sub, int i) { unsigned wd = mwb[tq[ct] * 128 + kt * 2 + sub]; return ((wd >> crow(i, h)) & 1u) != 0u; },
                     [&](int) { return 2; }, smem);
#pragma unroll
  for (int ct = 0; ct < NCT; ++ct) {
    const long tok = (long)b * S_ + tq[ct];
    float inv = st.l[ct] > 0.f ? 1.f / st.l[ct] : 0.f;
    write_out(st.o[ct], inv, p.U + tok * NPO + O_CGATE + hd * 64, p.mix + tok * 1280 + hd * 64, h);
  }
}

DI void nsa_item(const Params& p, int item, char* smem) {
  const int qb = 127 - (item >> 4), bg = item & 15, b = bg >> 1, g = bg & 1;
  const int tid = tidx(), lane = tid & 63, w = __builtin_amdgcn_readfirstlane(tid >> 6), r = lane & 31, h = lane >> 5;
  const int q0 = qb * 32, cur = q0 >> 6;
  bf16_t* Ks = (bf16_t*)smem; bf16_t* Vs = (bf16_t*)(smem + 13312);
  float* imp = (float*)(smem + 22528);
  unsigned long long* selm = (unsigned long long*)(smem + 30720);
  unsigned long long* uni = (unsigned long long*)(smem + 30976);
  const int ql = w * 8 + (r >> 2), tq = q0 + ql, hd = g * 4 + (r & 3);
  const long tok = (long)b * S_ + tq;
  bf16x8 qf[1][4];
  load_q<64>(qf[0], p.U + tok * NPE + E_BQ + hd * 64, h);
  const float sc2 = 0.125f * LOG2E;
  float* oaccL = (float*)(smem + 32768) + tid;
  const float* gatep = p.misc + tok * 32 + hd * 3;
  for (int i = tid; i < 32 * 64; i += 256) imp[i] = 0.f;

  KVSrc csrc; csrc.k1 = p.kcmp + (long)b * 256 * 128 + g * 64; csrc.ks1 = 128; csrc.k2 = csrc.k1; csrc.ks2 = 0; csrc.v = p.vcmp + (long)b * 256 * 128 + g * 64; csrc.vs = 128;
  const int nmax = q0 >> 4;
  const int nct = (nmax >> 6) + 1;
  FState<1> st; fs_init(st);
  auto cmask = [&](int kt, int sub, int i) { int n = kt * 64 + sub * 32 + crow(i, h); return 16 * n + 31 <= tq; };
  attn_pass<64, 1>(csrc, 0, nct, 255, qf, st, sc2, [&](int kt, int, int sub, int i) { return cmask(kt, sub, i); }, [&](int) { return 2; }, smem);
  const float linv = st.l[0] > 0.f ? 1.f / st.l[0] : 0.f;
  const float mfin = st.m[0];
  const float g0l = sigmf(gatep[0]) * linv;
#pragma unroll
  for (int d = 0; d < 2; ++d)
#pragma unroll
    for (int i = 0; i < 16; ++i) oaccL[(d * 16 + i) * 256] = g0l * st.o[0][d][i];
  {
    u32x4 kr[2], vr[2];
    float carry = 0.f;
    for (int kt = 0; kt < nct; ++kt) {
      __syncthreads();
      kv_load<64>(csrc, kt * 64, 255, kr, vr, tid);
      kv_store<64>(Ks, Vs, kr, vr, tid);
      __syncthreads();
      f32x16 s[2];
      score_tile<64, true>(Ks, qf[0], s, [&](int sub, int i) { return cmask(kt, sub, i); }, r, h);
#pragma unroll
      for (int sub = 0; sub < 2; ++sub) {
        float pr[16];
#pragma unroll
        for (int i = 0; i < 16; ++i) pr[i] = ex2(fmaf(s[sub][i], sc2, -mfin)) * linv;
        float part[4];
#pragma unroll
        for (int g4 = 0; g4 < 4; ++g4) part[g4] = __shfl_xor(pr[4 * g4 + 3], 32);
#pragma unroll
        for (int g4 = 0; g4 < 4; ++g4) {
          float gs = pr[4 * g4] + pr[4 * g4 + 1] + pr[4 * g4 + 2] + pr[4 * g4 + 3];
          float ex = h ? part[g4] : (g4 > 0 ? part[g4 - 1] : carry);
          float v = gs + ex;
          v += __shfl_xor(v, 1); v += __shfl_xor(v, 2);
          int j = kt * 16 + sub * 8 + 2 * g4 + h;
          if ((r & 3) == 0) imp[ql * 64 + j] = v;
        }
        carry = part[3];
      }
    }
  }
  __syncthreads();
  {
    unsigned long long wun = 0ull;
    for (int qi = 0; qi < 8; ++qi) {
      int qq = w * 8 + qi; int t = q0 + qq;
      int j = lane;
      float forced = (j == cur) ? 3e4f : ((j == cur - 1) ? 2e4f : ((j == 0) ? 1e4f : 0.f));
      float sc = (64 * j <= t) ? imp[qq * 64 + j] + forced : NEGF;
      int rank = 0;
#pragma unroll
      for (int i = 0; i < 64; ++i) {
        float si = __uint_as_float(__builtin_amdgcn_readlane(__float_as_uint(sc), i));
        rank += (si > sc || (si == sc && i < j)) ? 1 : 0;
      }
      unsigned long long m = __ballot(rank < 16 && 64 * j <= t);
      if (lane == 0) selm[qq] = m;
      wun |= m;
    }
    if (lane == 0) uni[w] = wun;
  }
  __syncthreads();
  const unsigned long long un = uni[0] | uni[1] | uni[2] | uni[3];
  const unsigned long long sm = selm[ql];
  {
    KVSrc ssrc; ssrc.k1 = p.U + (long)b * S_ * NPE + E_BKS + g * 64; ssrc.ks1 = NPE; ssrc.k2 = ssrc.k1; ssrc.ks2 = 0; ssrc.v = p.U + (long)b * S_ * NPE + E_BVS + g * 64; ssrc.vs = NPE;
    fs_init(st);
    u32x4 kr[2], vr[2];
    unsigned long long rem = un;
    int j = rem ? __builtin_ctzll(rem) : -1;
    if (j >= 0) kv_load<64>(ssrc, j * 64, S_, kr, vr, tid);
    while (j >= 0) {
      rem &= rem - 1;
      int jn = rem ? __builtin_ctzll(rem) : -1;
      __syncthreads();
      kv_store<64>(Ks, Vs, kr, vr, tid);
      __syncthreads();
      if (jn >= 0) kv_load<64>(ssrc, jn * 64, S_, kr, vr, tid);
      bool b0 = (sm >> j) & 1ull;
      if (__ballot(b0) != 0ull)
        flash_tile<64, 1, true>(Ks, Vs, qf, st, sc2, [&](int, int sub, int i) { return b0 && (j * 64 + sub * 32 + crow(i, h) <= tq); }, lane);
      j = jn;
    }
    float li = (st.l[0] > 0.f ? 1.f / st.l[0] : 0.f) * sigmf(gatep[1]);
#pragma unroll
    for (int d = 0; d < 2; ++d)
#pragma unroll
      for (int i = 0; i < 16; ++i) oaccL[(d * 16 + i) * 256] += li * st.o[0][d][i];
  }
  {
    KVSrc wsrc; wsrc.k1 = p.U + (long)b * S_ * NPE + E_BKW + g * 64; wsrc.ks1 = NPE; wsrc.k2 = wsrc.k1; wsrc.ks2 = 0; wsrc.v = p.U + (long)b * S_ * NPE + E_BVW + g * 64; wsrc.vs = NPE;
    fs_init(st);
    int kt0 = q0 - 511 < 0 ? 0 : (q0 - 511) >> 6;
    attn_pass<64, 1>(wsrc, kt0, cur + 1, S_, qf, st, sc2,
                     [&](int kt, int, int sub, int i) { int key = kt * 64 + sub * 32 + crow(i, h); return key <= tq && key > tq - 512; },
                     [&](int kt) { return (kt * 64 + 63 <= q0 + w * 8 && kt * 64 > q0 + w * 8 + 7 - 512) ? 1 : 2; }, smem);
    float li = (st.l[0] > 0.f ? 1.f / st.l[0] : 0.f) * sigmf(gatep[2]);
#pragma unroll
    for (int d = 0; d < 2; ++d)
#pragma unroll
      for (int i = 0; i < 16; ++i) st.o[0][d][i] = oaccL[(d * 16 + i) * 256] + li * st.o[0][d][i];
  }
  write_out(st.o[0], 1.f, p.U + tok * NPE + E_BGATE + hd * 64, p.mix + tok * 1280 + 512 + hd * 64, h);
  __syncthreads();
}

DI void cmp_item(const Params& p, int li, int item, char* smem) {
  const int kv = item & 1, tile = item >> 1;
  const int tid = tidx(), lane = tid & 63, w = __builtin_amdgcn_readfirstlane(tid >> 6), r = lane & 31, h = lane >> 5;
  float* part = (float*)smem;
  float* h1 = (float*)(smem + 33280);
  float* o2 = (float*)(smem + 41600);
  const int idx = tile * 32 + r;
  const bool rv = idx < NB * 255 * 2;
  const int bb = rv ? idx / 510 : 0, rem = rv ? idx % 510 : 0, n = rem >> 1, g = rem & 1;
  const bf16_t* arow = p.U + ((long)(bb * S_ + 16 * n)) * NPE + (kv ? E_BVC : E_BKC) + g * 64;
  const float* pe = p.nsa_cmp_pos + (long)(li * 2 + kv) * 32 * 64;
  const bf16_t* W1 = p.Wc1T + (long)(li * 2 + kv) * 64 * 2048;
  f32x16 acc[2] = {zero16(), zero16()};
  for (int ks_ = 0; ks_ < 32; ++ks_) {
    int ks = ks_; asm volatile("" : "+s"(ks));
    int k = w * 512 + ks * 16 + 8 * h; int l = k >> 6, d = k & 63;
    u32x4 av = *(const u32x4*)(arow + (long)l * NPE + d);
    float4 pa = *(const float4*)(pe + l * 64 + d), pb = *(const float4*)(pe + l * 64 + d + 4);
    u32x4 af;
    af.x = pk2(bflo(av.x) + pa.x, bfhi(av.x) + pa.y); af.y = pk2(bflo(av.y) + pa.z, bfhi(av.y) + pa.w);
    af.z = pk2(bflo(av.z) + pb.x, bfhi(av.z) + pb.y); af.w = pk2(bflo(av.w) + pb.z, bfhi(av.w) + pb.w);
    bf16x8 a = __builtin_bit_cast(bf16x8, af);
#pragma unroll
    for (int nt = 0; nt < 2; ++nt) {
      bf16x8 bfr = *(const bf16x8*)(W1 + (long)(nt * 32 + r) * 2048 + k);
      acc[nt] = mfma32(a, bfr, acc[nt]);
    }
  }
  __syncthreads();
#pragma unroll
  for (int nt = 0; nt < 2; ++nt)
#pragma unroll
    for (int i = 0; i < 16; ++i) part[(w * 32 + crow(i, h)) * 65 + nt * 32 + r] = acc[nt][i];
  __syncthreads();
  for (int e = tid; e < 32 * 64; e += 256) {
    int rr = e >> 6, cc = e & 63;
    float v = part[rr * 65 + cc] + part[(32 + rr) * 65 + cc] + part[(64 + rr) * 65 + cc] + part[(96 + rr) * 65 + cc];
    h1[rr * 65 + cc] = siluf(v);
  }
  __syncthreads();
  {
    const float* W2 = p.nsa_cmp_w2 + (long)(li * 2 + kv) * 64 * 64;
    int rr = tid >> 3, c0 = (tid & 7) * 8;
    float o[8] = {0.f, 0.f, 0.f, 0.f, 0.f, 0.f, 0.f, 0.f};
    for (int i = 0; i < 64; ++i) {
      float hv = h1[rr * 65 + i];
      float4 wa = *(const float4*)(W2 + i * 64 + c0), wb = *(const float4*)(W2 + i * 64 + c0 + 4);
      o[0] += hv * wa.x; o[1] += hv * wa.y; o[2] += hv * wa.z; o[3] += hv * wa.w;
      o[4] += hv * wb.x; o[5] += hv * wb.y; o[6] += hv * wb.z; o[7] += hv * wb.w;
    }
#pragma unroll
    for (int j = 0; j < 8; ++j) o2[rr * 65 + c0 + j] = o[j];
  }
  __syncthreads();
  if (tid < 32) {
    int idx2 = tile * 32 + tid;
    if (idx2 < NB * 255 * 2) {
      int b2 = idx2 / 510, rem2 = idx2 % 510, n2 = rem2 >> 1, g2 = rem2 & 1;
      const float* row = o2 + tid * 65;
      bf16_t* dst = (kv ? p.vcmp : p.kcmp) + ((long)(b2 * 256 + n2)) * 128 + g2 * 64;
      if (kv) {
#pragma unroll 4
        for (int i = 0; i < 64; ++i) dst[i] = f2bf(row[i]);
      } else {
        float ss = 0.f;
#pragma unroll 4
        for (int i = 0; i < 64; ++i) ss += row[i] * row[i];
        float sc = rsqrtf(ss * (1.f / 64.f) + EPS);
        const float* gn = p.nsa_k_g + li * 192;
        const float* cs = p.rope64 + ((long)(b2 * S_ + 16 * n2 + 31)) * 64;
#pragma unroll 2
        for (int i = 0; i < 32; ++i) {
          float x1 = row[i] * sc * gn[i], x2 = row[i + 32] * sc * gn[i + 32];
          float co = cs[2 * i], si = cs[2 * i + 1];
          dst[i] = f2bf(x1 * co - x2 * si); dst[i + 32] = f2bf(x1 * si + x2 * co);
        }
      }
    }
  }
  __syncthreads();
}

DI unsigned mono(float f) { unsigned u = __float_as_uint(f); return (u & 0x80000000u) ? ~u : (u | 0x80000000u); }
DI int red32(int v) {
  v += __builtin_amdgcn_update_dpp(0, v, 0xB1, 0xF, 0xF, true);
  v += __builtin_amdgcn_update_dpp(0, v, 0x4E, 0xF, 0xF, true);
  v += __builtin_amdgcn_update_dpp(0, v, 0x141, 0xF, 0xF, true);
  v += __builtin_amdgcn_update_dpp(0, v, 0x140, 0xF, 0xF, true);
  v += __shfl_xor(v, 16);
  return v;
}

DI void dsa_select_item(const Params& p, int item, char* smem) {
  const int idx_ = item >> 3, zk_ = idx_ >> 6, zj_ = idx_ & 63;
  const int b = item & 7, q8 = 511 - ((zk_ & 1) ? (zk_ * 64 + 63 - zj_) : idx_);
  const int tid_ = tidx();
  const int lane = tid_ & 63, w = __builtin_amdgcn_readfirstlane(tid_ >> 6);
  const int hq = lane >> 5, l16 = lane & 15, g16 = lane >> 4, bit = g16 & 1;
  const int tqa = q8 * 8 + 2 * w, tq = tqa + hq, tqb = tqa + 1;
  const long tokb = (long)b * S_;
  bf16x8 af = *(const bf16x8*)(p.U + (tokb + tqa + (l16 >> 3)) * NPO + O_CIQ + (l16 & 7) * 32 + 8 * g16);
  float iw[4];
#pragma unroll
  for (int j = 0; j < 4; ++j) iw[j] = p.misc[(tokb + tq) * 32 + bit * 4 + j] * 0.35355339059327373f;
  unsigned ku[64];
  unsigned* kl = (unsigned*)smem + w * 4096 + lane;
  const int imax = tqb >> 5;
  const char* ikb = (const char*)(p.U + tokb * NPO + O_CIK);
  const unsigned voff = (unsigned)(l16 * NPO + 8 * g16) * 2u;
  auto score = [&](int i) -> unsigned {
    const char* sb = ikb + (size_t)i * (32 * NPO * 2);
    bf16x8 b0 = *(const bf16x8*)(sb + voff);
    bf16x8 b1 = *(const bf16x8*)(sb + 16 * NPO * 2 + voff);
    f32x4 z = {0.f, 0.f, 0.f, 0.f};
    f32x4 c0 = __builtin_amdgcn_mfma_f32_16x16x32_bf16(af, b0, z, 0, 0, 0);
    f32x4 c1 = __builtin_amdgcn_mfma_f32_16x16x32_bf16(af, b1, z, 0, 0, 0);
    float sA = iw[0] * fmaxf(c0[0], 0.f) + iw[1] * fmaxf(c0[1], 0.f) + iw[2] * fmaxf(c0[2], 0.f) + iw[3] * fmaxf(c0[3], 0.f);
    float sB = iw[0] * fmaxf(c1[0], 0.f) + iw[1] * fmaxf(c1[1], 0.f) + iw[2] * fmaxf(c1[2], 0.f) + iw[3] * fmaxf(c1[3], 0.f);
    float keep = bit ? sB : sA, send = bit ? sA : sB;
    float sc = keep + __shfl_xor(send, 16);
    int key = 32 * i + (lane & 31);
    return mono(key <= tq ? sc : NEGF);
  };
#pragma unroll
  for (int c = 0; c < 8; ++c) {
    if (8 * c <= imax) {
#pragma unroll
      for (int j = 0; j < 8; ++j) ku[8 * c + j] = score(8 * c + j);
    } else {
#pragma unroll
      for (int j = 0; j < 8; ++j) ku[8 * c + j] = 0u;
    }
  }
  const int iend = imax < 64 ? 63 : (imax | 3);
  for (int i = 64; i <= iend; i += 4) {
    unsigned k0 = score(i), k1 = score(i + 1), k2 = score(i + 2), k3 = score(i + 3);
    kl[(i - 64) * 64] = k0; kl[(i - 63) * 64] = k1; kl[(i - 62) * 64] = k2; kl[(i - 61) * 64] = k3;
  }
  unsigned thr = 0u; int need = 1 << 20;
  unsigned* mw = p.maskw + (tokb + tq) * 128;
  const unsigned lowmask = (1u << (lane & 31)) - 1u;
  int run = 0;
  auto emit = [&](int i, unsigned kv) {
    bool eq = kv == thr, gt = kv > thr;
    unsigned long long bal = __ballot(eq);
    unsigned mine = hq ? (unsigned)(bal >> 32) : (unsigned)bal;
    int pre = __popc(mine & lowmask);
    bool sel = gt || (eq && (run + pre < need));
    run += __popc(mine);
    sel = sel && (32 * i + (lane & 31) <= tq);
    unsigned long long sb = __ballot(sel);
    unsigned word = hq ? (unsigned)(sb >> 32) : (unsigned)sb;
    if ((lane & 31) == 0) mw[i] = word;
  };
  if (imax < 64) {
    if (tqa >= 256) {
      bool done = false;
      for (int bt = 31; bt >= 0; --bt) {
        unsigned cand = thr | (1u << bt);
        int cnt = 0;
#pragma unroll
        for (int i = 0; i < 64; ++i) cnt += (ku[i] >= cand) ? 1 : 0;
        cnt = red32(cnt);
        if (!done) { thr = cnt >= 256 ? cand : thr; done = (cnt == 256); }
        if (__all(done)) break;
      }
      int cg = 0;
#pragma unroll
      for (int i = 0; i < 64; ++i) cg += (ku[i] > thr) ? 1 : 0;
      need = 256 - red32(cg);
    }
#pragma unroll
    for (int i = 0; i < 64; ++i) emit(i, ku[i]);
    for (int i = 64; i < 128; ++i) { if ((lane & 31) == 0) mw[i] = 0u; }
  } else {
    unsigned k2[64];
#pragma unroll
    for (int j = 0; j < 64; ++j) { unsigned v = kl[j * 64]; k2[j] = (64 + j <= iend) ? v : 0u; }
    bool done = false;
    for (int bt = 31; bt >= 0; --bt) {
      unsigned cand = thr | (1u << bt);
      int cnt = 0;
#pragma unroll
      for (int i = 0; i < 64; ++i) cnt += ((ku[i] >= cand) ? 1 : 0) + ((k2[i] >= cand) ? 1 : 0);
      cnt = red32(cnt);
      if (!done) { thr = cnt >= 256 ? cand : thr; done = (cnt == 256); }
      if (__all(done)) break;
    }
    int cg = 0;
#pragma unroll
    for (int i = 0; i < 64; ++i) cg += ((ku[i] > thr) ? 1 : 0) + ((k2[i] > thr) ? 1 : 0);
    need = 256 - red32(cg);
#pragma unroll
    for (int i = 0; i < 64; ++i) emit(i, ku[i]);
#pragma unroll
    for (int i = 0; i < 64; ++i) emit(64 + i, k2[i]);
  }
}

DI f32x16 mfmaf(float a, float b, f32x16 c) { return __builtin_amdgcn_mfma_f32_32x32x2f32(a, b, c, 0, 0, 0); }

DI void mlstm_stage(const Params& p, int li, int hd, long t0, int cidx, float* QW, float* Kl, float* Vl, bool needq, int tid, int w, int lane) {
  const float* cw = p.conv_w + (long)li * 4 * 512; const float* cb = p.conv_b + li * 512;
  const int d = lane;
#pragma unroll
  for (int which = 0; which < 2; ++which) {
    if (which == 0 && !needq) continue;
    int ch = which * 256 + hd * 64 + d;
    const bf16_t* up = p.U + t0 * NPO + (which ? O_DK : O_DQ) + hd * 64 + d;
    float w0 = cw[ch], w1 = cw[512 + ch], w2 = cw[1024 + ch], w3 = cw[1536 + ch], bias = cb[ch];
    int tl0 = w * 16;
    int s0 = cidx * 64 + tl0;
    float x0 = (s0 - 3 >= 0) ? bf2f(up[(long)(tl0 - 3) * NPO]) : 0.f;
    float x1 = (s0 - 2 >= 0) ? bf2f(up[(long)(tl0 - 2) * NPO]) : 0.f;
    float x2 = (s0 - 1 >= 0) ? bf2f(up[(long)(tl0 - 1) * NPO]) : 0.f;
    float* dstl = which ? Kl : QW;
#pragma unroll 4
    for (int i = 0; i < 16; ++i) {
      float x3 = bf2f(up[(long)(tl0 + i) * NPO]);
      float y = bias + w0 * x0 + w1 * x1 + w2 * x2 + w3 * x3;
      y = siluf(y);
      if (which) y *= 0.125f;
      dstl[(tl0 + i) * 65 + d] = y;
      x0 = x1; x1 = x2; x2 = x3;
    }
  }
#pragma unroll
  for (int i = 0; i < 4; ++i) {
    int cidx2 = tid + 256 * i; int tl = cidx2 >> 4, vc8 = (cidx2 & 15) * 8;
    u32x4 vv = *(const u32x4*)(p.U + (t0 + tl) * NPO + O_DV + hd * 128 + vc8);
    float4 a, bq;
    a.x = bflo(vv.x); a.y = bfhi(vv.x); a.z = bflo(vv.y); a.w = bfhi(vv.y);
    bq.x = bflo(vv.z); bq.y = bfhi(vv.z); bq.z = bflo(vv.w); bq.w = bfhi(vv.w);
    *(float4*)(Vl + tl * 128 + vc8) = a; *(float4*)(Vl + tl * 128 + vc8 + 4) = bq;
  }
}

DI void mlstm_x(const Params& p, int li, int item, char* smem) {
  const int c = item & 63, bh = item >> 6, b = bh >> 2, hd = bh & 3;
  const int tid = tidx(), lane = tid & 63, w = __builtin_amdgcn_readfirstlane(tid >> 6), r = lane & 31, h = lane >> 5;
  float* Kl = (float*)(smem + 16640); float* Vl = (float*)(smem + 33280); float* vws = (float*)(smem + 66048);
  const long t0 = (long)b * S_ + c * 64;
  const float ib = p.i_bias[li * 4 + hd], fb = p.f_bias[li * 4 + hd];
  mlstm_stage(p, li, hd, t0, c, nullptr, Kl, Vl, false, tid, w, lane);
  if (w == 0) {
    float ig = p.misc[(t0 + lane) * 32 + 8 + hd] + ib;
    float fp = p.misc[(t0 + lane) * 32 + 12 + hd] + fb;
    float lf = fminf(fp, 0.f) - log1pf(__expf(-fabsf(fp)));
    float bc = lf;
#pragma unroll
    for (int dlt = 1; dlt < 64; dlt <<= 1) { float t = __shfl_up(bc, dlt); if (lane >= dlt) bc += t; }
    float bL = __shfl(bc, 63);
    float g = bL - bc + ig;
    float gm = g;
#pragma unroll
    for (int dlt = 1; dlt < 64; dlt <<= 1) gm = fmaxf(gm, __shfl_xor(gm, dlt));
    vws[lane] = __expf(g - gm);
    if (lane == 0) { p.mS[(long)item * 4] = bL; p.mS[(long)item * 4 + 1] = gm; }
  }
  __syncthreads();
  f32x16 acc[2] = {zero16(), zero16()};
#pragma unroll
  for (int dt = 0; dt < 2; ++dt)
#pragma unroll 4
    for (int kk = 0; kk < 32; ++kk) {
      int s = 2 * kk + h;
      float a = Kl[s * 65 + dt * 32 + r] * vws[s];
      float bb = Vl[s * 128 + 32 * w + r];
      acc[dt] = mfmaf(a, bb, acc[dt]);
    }
  float* Ug = p.mU + (long)item * 8192 + 32 * w + r;
#pragma unroll
  for (int dt = 0; dt < 2; ++dt)
#pragma unroll
    for (int i = 0; i < 16; ++i) Ug[(dt * 32 + crow(i, h)) * 128] = acc[dt][i];
  if (w == 1) {
    float ns = 0.f;
    for (int s = 0; s < 64; ++s) ns += Kl[s * 65 + lane] * vws[s];
    p.mN[(long)item * 64 + lane] = ns;
  }
}

DI void mlstm_y(const Params& p, int item) {
  const int tid = tidx();
  const long base = (long)item * 64;
  f32x4 C[8], uc[8], un[8];
#pragma unroll
  for (int j = 0; j < 8; ++j) { C[j] = (f32x4){0.f, 0.f, 0.f, 0.f}; un[j] = C[j]; }
  float nn = 0.f, m = 0.f;
  float* Ub = p.mU + base * 8192 + tid * 32;
#pragma unroll
  for (int j = 0; j < 8; ++j) uc[j] = *(const f32x4*)(Ub + 4 * j);
  for (int c = 0; c < 64; ++c) {
    float bL = p.mS[(base + c) * 4], ml = p.mS[(base + c) * 4 + 1];
    float* Uc = Ub + (long)c * 8192;
    if (c + 1 < 64) {
#pragma unroll
      for (int j = 0; j < 8; ++j) un[j] = *(const f32x4*)(Uc + 8192 + 4 * j);
    }
    float mnew = fmaxf(bL + m, ml);
    float decay = __expf(bL + m - mnew), sc = __expf(ml - mnew);
#pragma unroll
    for (int j = 0; j < 8; ++j) { *(f32x4*)(Uc + 4 * j) = C[j]; C[j] = decay * C[j] + sc * uc[j]; uc[j] = un[j]; }
    if (tid == 0) p.mS[(base + c) * 4 + 2] = m;
    if (tid < 64) { float nu = p.mN[(base + c) * 64 + tid]; p.mN[(base + c) * 64 + tid] = nn; nn = decay * nn + sc * nu; }
    m = mnew;
  }
}

DI void mlstm_z(const Params& p, int li, int item, char* smem) {
  const int c = item & 63, bh = item >> 6, b = bh >> 2, hd = bh & 3;
  const int tid = tidx(), lane = tid & 63, w = __builtin_amdgcn_readfirstlane(tid >> 6), r = lane & 31, h = lane >> 5;
  float* QW = (float*)smem;
  float* Kl = (float*)(smem + 16640);
  float* Vl = (float*)(smem + 33280);
  float* vb = (float*)(smem + 66048);
  float* vc = vb + 64; float* vmt = vb + 128; float* va = vb + 192; float* nvec = vb + 320; float* vinv = vb + 384;
  const long t0 = (long)b * S_ + c * 64;
  const float ib = p.i_bias[li * 4 + hd], fb = p.f_bias[li * 4 + hd];
  mlstm_stage(p, li, hd, t0, c, QW, Kl, Vl, true, tid, w, lane);
  if (tid < 64) nvec[tid] = p.mN[(long)item * 64 + tid];
  if (w == 0) {
    const float mstate = p.mS[(long)item * 4 + 2];
    float ig = p.misc[(t0 + lane) * 32 + 8 + hd] + ib;
    float fp = p.misc[(t0 + lane) * 32 + 12 + hd] + fb;
    float lf = fminf(fp, 0.f) - log1pf(__expf(-fabsf(fp)));
    float bc = lf;
#pragma unroll
    for (int dlt = 1; dlt < 64; dlt <<= 1) { float t = __shfl_up(bc, dlt); if (lane >= dlt) bc += t; }
    float cc = ig - bc;
    float pm = cc;
#pragma unroll
    for (int dlt = 1; dlt < 64; dlt <<= 1) { float t = __shfl_up(pm, dlt); if (lane >= dlt) pm = fmaxf(pm, t); }
    float mt = bc + fmaxf(mstate, pm);
    float aa = __expf(bc + mstate - mt);
    vb[lane] = bc; vc[lane] = cc; vmt[lane] = mt; va[lane] = aa;
  }
  __syncthreads();
  float qn = 0.f;
  if (w == 0) { for (int d = 0; d < 64; ++d) qn += QW[lane * 65 + d] * nvec[d]; }
  f32x16 hacc[2] = {zero16(), zero16()};
  {
    const float* Cg = p.mU + (long)item * 8192 + 32 * w + r;
#pragma unroll 8
    for (int kk = 0; kk < 32; ++kk) {
      float bb = Cg[(2 * kk + h) * 128];
      float a0 = QW[r * 65 + 2 * kk + h], a1 = QW[(32 + r) * 65 + 2 * kk + h];
      hacc[0] = mfmaf(a0, bb, hacc[0]);
      hacc[1] = mfmaf(a1, bb, hacc[1]);
    }
  }
  f32x16 sacc = zero16();
  const int tt_s = w >> 1, st_s = w & 1;
#pragma unroll 4
  for (int kk = 0; kk < 32; ++kk) {
    float a = QW[(tt_s * 32 + r) * 65 + 2 * kk + h];
    float bb = Kl[(st_s * 32 + r) * 65 + 2 * kk + h];
    sacc = mfmaf(a, bb, sacc);
  }
  __syncthreads();
  {
    int s = st_s * 32 + r; float cs_ = vc[s];
#pragma unroll
    for (int i = 0; i < 16; ++i) {
      int t = tt_s * 32 + crow(i, h);
      float wv = (s <= t) ? sacc[i] * __expf(vb[t] - vmt[t] + cs_) : 0.f;
      QW[t * 65 + s] = wv;
    }
  }
  __syncthreads();
#pragma unroll
  for (int tt = 0; tt < 2; ++tt)
#pragma unroll
    for (int i = 0; i < 16; ++i) hacc[tt][i] *= va[tt * 32 + crow(i, h)];
#pragma unroll 4
  for (int kk = 0; kk < 32; ++kk) {
    float bb = Vl[(2 * kk + h) * 128 + 32 * w + r];
    float a0 = QW[r * 65 + 2 * kk + h], a1 = QW[(32 + r) * 65 + 2 * kk + h];
    hacc[0] = mfmaf(a0, bb, hacc[0]);
    hacc[1] = mfmaf(a1, bb, hacc[1]);
  }
  if (w == 0) {
    float rsum = 0.f;
    for (int s = 0; s < 64; ++s) rsum += QW[lane * 65 + s];
    float den = va[lane] * qn + rsum;
    float dn = fmaxf(fabsf(den), __expf(-vmt[lane]));
    vinv[lane] = 1.f / dn;
  }
  __syncthreads();
#pragma unroll
  for (int tt = 0; tt < 2; ++tt)
#pragma unroll
    for (int i = 0; i < 16; ++i) { int t = tt * 32 + crow(i, h); Vl[t * 128 + 32 * w + r] = hacc[tt][i] * vinv[t]; }
  __syncthreads();
  {
    int t = tid >> 2, q = tid & 3;
    const float* hr = Vl + t * 128 + q * 32;
    float ss = 0.f;
#pragma unroll
    for (int i = 0; i < 8; ++i) { float4 v = ((const float4*)hr)[i]; ss += v.x * v.x + v.y * v.y + v.z * v.z + v.w * v.w; }
    ss += __shfl_xor(ss, 1); ss += __shfl_xor(ss, 2);
    float rn = rsqrtf(ss * (1.f / 128.f) + EPS);
    const float* gn = p.h_norm_g + li * 128 + q * 32;
    const bf16_t* op = p.U + (t0 + t) * NPO + O_DO + hd * 128 + q * 32;
    const bf16_t* gp = p.U + (t0 + t) * NPO + O_DGATE + hd * 128 + q * 32;
    bf16_t* dst = p.mix + (t0 + t) * 1280 + 512 + hd * 128 + q * 32;
#pragma unroll
    for (int cch = 0; cch < 4; ++cch) {
      u32x4 ov = *(const u32x4*)(op + cch * 8), gv = *(const u32x4*)(gp + cch * 8);
      float y[8];
#pragma unroll
      for (int j = 0; j < 8; ++j) y[j] = hr[cch * 8 + j] * rn * gn[cch * 8 + j];
      y[0] *= sigmf(bflo(ov.x)) * siluf(bflo(gv.x)); y[1] *= sigmf(bfhi(ov.x)) * siluf(bfhi(gv.x));
      y[2] *= sigmf(bflo(ov.y)) * siluf(bflo(gv.y)); y[3] *= sigmf(bfhi(ov.y)) * siluf(bfhi(gv.y));
      y[4] *= sigmf(bflo(ov.z)) * siluf(bflo(gv.z)); y[5] *= sigmf(bfhi(ov.z)) * siluf(bfhi(gv.z));
      y[6] *= sigmf(bflo(ov.w)) * siluf(bflo(gv.w)); y[7] *= sigmf(bfhi(ov.w)) * siluf(bfhi(gv.w));
      u32x4 o; o.x = pk2(y[0], y[1]); o.y = pk2(y[2], y[3]); o.z = pk2(y[4], y[5]); o.w = pk2(y[6], y[7]);
      *(u32x4*)(dst + cch * 8) = o;
    }
  }
}

DI int inproj_count(int layer) { return 256 * (((layer & 1) ? NPO : NPE) / 128) + (layer == 0 ? 256 : 0); }
DI void inproj_task(const Params& p, int layer, int t, char* smem) {
  const bool odd = layer & 1; const int li = layer >> 1;
  const int NP = odd ? NPO : NPE; const int ntn = NP / 128; const int nin = 256 * ntn;
#define ROWF [&](int row, const float* v, float rs)
  if (t < nin) {
    int mt = t / ntn, nt = t % ntn;
    if (!odd) {
      gemm_tile<true>(p.xb, DM, p.WinT[layer], DM, mt * 128, nt * 128, smem, [&](int gi, int c8, auto run) {
        bf16_t* d0 = p.U + gi * 64;
        auto n64 = [&](const float* g, bool rope) {
          if (rope) run(ROWF { ep_norm64(v, c8, rs, g, p.rope64 + (long)row * 64, d0 + (long)row * NPE); });
          else run(ROWF { ep_norm64(v, c8, rs, g, nullptr, d0 + (long)row * NPE); });
        };
        if (gi == 6) {
          if (c8 < 4) run(ROWF { ep_head<16, true>(v, 0, c8, rs, p.mla_k_norm_g + li * 96 + 64, p.rope32 + (long)row * 32, d0 + (long)row * NPE); });
          else run(ROWF { ep_zero(c8, d0 + (long)row * NPE); });
        }
        else if (gi >= 15 && gi < 23) n64(p.nsa_q_g + li * 64, true);
        else if (gi == 27 || gi == 28) n64(p.nsa_k_g + li * 192 + 64, true);
        else if (gi == 31 || gi == 32) n64(p.nsa_k_g + li * 192 + 128, true);
        else if (gi >= 43 && gi < 47) n64(p.mem_q_g + layer * 64, false);
        else if (gi == 51) { if (c8 < 3) run(ROWF { float x[8]; ld8(v + 8 * c8, x);
#pragma unroll
            for (int j = 0; j < 8; ++j) p.misc[(long)row * 32 + 8 * c8 + j] = x[j] * rs; }); }
        else run(ROWF { ep_plain(v, c8, rs, d0 + (long)row * NPE); });
      });
    } else {
      gemm_tile<true>(p.xb, DM, p.WinT[layer], DM, mt * 128, nt * 128, smem, [&](int gi, int c8, auto run) {
        bf16_t* d0 = p.U + gi * 64;
        if (gi <= 8) { const float* g = (gi < 8 ? p.dsa_q_g : p.dsa_k_g) + li * 64;
          run(ROWF { ep_norm64(v, c8, rs, g, p.rope64 + (long)row * 64, d0 + (long)row * NPO); }); }
        else if (gi >= 10 && gi < 14) run(ROWF { ep_head<16, false>(v, (c8 >> 2) * 32, c8 & 3, rs, nullptr, p.rope32 + (long)row * 32, d0 + (long)row * NPO); });
        else if (gi == 14) {
          if (c8 < 4) run(ROWF { ep_head<16, false>(v, 0, c8, rs, nullptr, p.rope32 + (long)row * 32, d0 + (long)row * NPO); });
          else run(ROWF { ep_zero(c8, d0 + (long)row * NPO); });
        }
        else if (gi >= 55 && gi < 59) { const float* g = p.mem_q_g + layer * 64; run(ROWF { ep_norm64(v, c8, rs, g, nullptr, d0 + (long)row * NPO); }); }
        else if (gi == 63) { if (c8 < 2) run(ROWF { float x[8]; ld8(v + 8 * c8, x);
#pragma unroll
            for (int j = 0; j < 8; ++j) p.misc[(long)row * 32 + 8 * c8 + j] = x[j] * rs; }); }
        else run(ROWF { ep_plain(v, c8, rs, d0 + (long)row * NPO); });
      });
    }
  } else {
    int u = t - nin; int l = u >> 6, mt = (u >> 2) & 15, nt = u & 3;
    gemm_tile<true>(p.memb, DM, p.WmemT + (long)l * 512 * 1024, DM, mt * 128, nt * 128, smem, [&](int gi, int c8, auto run) {
      if (gi < 4) run(ROWF { ep_norm64(v, c8, rs, p.mem_k_g + l * 64, nullptr, p.memk + ((long)l * 2048 + row) * 256 + gi * 64); });
      else run(ROWF { ep_plain(v, c8, rs, p.memv + ((long)l * 2048 + row) * 256 + (gi - 4) * 64); });
    });
  }
}
constexpr int NPREP = 2048 + 2048 + 256;
DI void prep_task(const Params& p, int li, int t, char* smem) {
  const int ncmp = 256, nuq = 2048;
  if (t < ncmp) {
    __syncthreads();
    cmp_item(p, li, t, smem);
  } else if (t < ncmp + nuq) {
    int u0 = t - ncmp; int mt = u0 >> 3, hd = u0 & 7;
    gemm_tile<true>(p.U + E_AQL, NPE, p.WuqT + (long)li * 1024 * 256, 256, mt * 128, hd * 128, smem, [&](int gi, int c8, auto run) {
      bf16_t* d0 = p.qbuf + hd * 96;
      if ((gi & 1) == 0) run(ROWF { ep_norm64(v, c8, rs, p.mla_q_norm_g + li * 96, nullptr, d0 + (long)row * 768); });
      else if (c8 < 4) run(ROWF { ep_head<16, true>(v, 0, c8, rs, p.mla_q_norm_g + li * 96 + 64, p.rope32 + (long)row * 32, d0 + (long)row * 768 + 64); });
    });
  } else {
    int u = t - ncmp - nuq; int mt = u >> 3, hd = u & 7;
    gemm_tile<true>(p.U + E_AKVL, NPE, p.WukvT + (long)li * 1024 * 128, 128, mt * 128, hd * 128, smem, [&](int gi, int c8, auto run) {
      if ((gi & 1) == 0) run(ROWF { ep_norm64(v, c8, rs, p.mla_k_norm_g + li * 96, nullptr, p.kbuf + (long)row * 512 + hd * 64); });
      else run(ROWF { ep_plain(v, c8, rs, p.vbuf + (long)row * 512 + hd * 64); });
    });
  }
}
DI void outproj_task(const Params& p, int layer, int t, char* smem) {
  const float* xold = (layer == 0) ? p.x : p.out;
  int mt = t >> 3, nt = t & 7;
  gemm_tile<false>(p.mix, 1280, p.WoutT + (long)layer * 1024 * 1280, 1280, mt * 128, nt * 128, smem, [&](int gi, int c8, auto run) {
    run(ROWF {
      const long o = (long)row * DM + gi * 64 + 8 * c8;
      float x[8]; ld8(v + 8 * c8, x);
      float4 xa = *(const float4*)(xold + o), xb2 = *(const float4*)(xold + o + 4);
      x[0] += xa.x; x[1] += xa.y; x[2] += xa.z; x[3] += xa.w; x[4] += xb2.x; x[5] += xb2.y; x[6] += xb2.z; x[7] += xb2.w;
      *(float4*)(p.out + o) = *(float4*)&x[0]; *(float4*)(p.out + o + 4) = *(float4*)&x[4];
      st8bf(p.xb + o, x);
    });
  });
}
#undef ROWF

typedef const __attribute__((address_space(4))) Params* KParams;
DI const Params& kparams() {
  KParams kp = (KParams)__builtin_amdgcn_kernarg_segment_ptr();
  asm volatile("" : "+s"(kp));
  return *(const Params*)kp;
}
DI int snake(int k, int t0, int bid, int nb, int total) { int tr = k * nb + (nb - 1 - bid); return ((k & 1) && (k + 1) * nb <= total) ? tr : t0; }
#define XB_TMO      128
#define XB_XCNT(j)  (256  + 64 * (j))
#define XB_XSUB(j)  (1280 + 64 * (j))
#define XB_XGEN(j)  (2304 + 64 * (j))
#define XB_TOP      3328
#define XB_TOPGEN   3392
#define XCD_BAR_WORDS 3456
#define XB_SPIN_CAP (1u << 22)
#define LAS __attribute__((address_space(3)))
DI unsigned xb_ld(unsigned* p) { return __hip_atomic_load(p, __ATOMIC_RELAXED, __HIP_MEMORY_SCOPE_AGENT); }
DI unsigned xb_add(unsigned* p, unsigned v) { return __hip_atomic_fetch_add(p, v, __ATOMIC_RELAXED, __HIP_MEMORY_SCOPE_AGENT); }
DI unsigned xb_xcc_id() { return (unsigned)__builtin_amdgcn_s_getreg((3 << 11) | 20) & 0xFu; }
#define XB_SPIN(cond, bar) do { unsigned _sp = 0; while (cond) { __builtin_amdgcn_s_sleep(1); \
    if ((++_sp & 255u) == 0u) { if (xb_ld(&(bar)[XB_TMO])) break; if (_sp > XB_SPIN_CAP) { atomicAdd(&(bar)[XB_TMO], 1u); break; } } } } while (0)
struct XcdBarrier { unsigned* bar; unsigned x; volatile LAS unsigned* st; };
DI XcdBarrier xcd_barrier_post(unsigned* bar, volatile LAS unsigned* st) {
  XcdBarrier b; b.bar = bar; b.x = xb_xcc_id(); b.st = st;
  if (threadIdx.x == 0) (void)xb_add(&bar[XB_XCNT(b.x)], 1u);
  return b;
}
DI void xcd_barrier_complete(unsigned* bar, unsigned x, unsigned& nloc, unsigned& nx) {
  const unsigned G = gridDim.x * gridDim.y * gridDim.z;
  unsigned sum, cnt, mine, sp = 0u;
  for (;;) {
    sum = 0u; cnt = 0u; mine = 0u;
#pragma unroll
    for (unsigned j = 0; j < 16; ++j) { const unsigned c = xb_ld(&bar[XB_XCNT(j)]); sum += c; cnt += (c > 0u) ? 1u : 0u; mine = (j == x) ? c : mine; }
    if (sum == G) break;
    __builtin_amdgcn_s_sleep(1);
    if ((++sp & 255u) == 0u) { if (xb_ld(&bar[XB_TMO])) break; if (sp > XB_SPIN_CAP) { atomicAdd(&bar[XB_TMO], 1u); break; } }
  }
  nloc = mine > 0u ? mine : 1u; nx = cnt > 0u ? cnt : 1u;
}
DI void xcd_barrier(const XcdBarrier& b) {
  asm volatile("s_waitcnt vmcnt(0)" ::: "memory");
  __syncthreads();
  if (threadIdx.x == 0) {
    unsigned* bar = b.bar;
    __builtin_amdgcn_s_waitcnt(0);
    unsigned nloc = b.st[0], nx = b.st[1];
    if (nloc == 0u) { xcd_barrier_complete(bar, b.x, nloc, nx); b.st[0] = nloc; b.st[1] = nx; }
    const unsigned old = xb_add(&bar[XB_XSUB(b.x)], 1u);
    const unsigned gen = old / nloc;
    if (old + 1u == (gen + 1u) * nloc) {
      __builtin_amdgcn_fence(__ATOMIC_RELEASE, "agent");
      asm volatile("s_waitcnt vmcnt(0)" ::: "memory");
      const unsigned og = xb_add(&bar[XB_TOP], 1u);
      const unsigned tg = og / nx;
      if (og + 1u == (tg + 1u) * nx) xb_add(&bar[XB_TOPGEN], 1u);
      else XB_SPIN(xb_ld(&bar[XB_TOPGEN]) == tg, bar);
      __builtin_amdgcn_fence(__ATOMIC_ACQUIRE, "agent");
      xb_add(&bar[XB_XGEN(b.x)], 1u);
      asm volatile("s_waitcnt vmcnt(0)" ::: "memory");
    } else {
      XB_SPIN(xb_ld(&bar[XB_XGEN(b.x)]) == gen, bar);
      __builtin_amdgcn_fence(__ATOMIC_ACQUIRE, "agent");
      asm volatile("s_waitcnt vmcnt(0)" ::: "memory");
    }
  }
  __syncthreads();
}
#define SMEM_DECL __shared__ __attribute__((aligned(16))) char smem[SMEM_BYTES]
__global__ void __launch_bounds__(256, 2) mega(Params p_) {
  SMEM_DECL;
  cg::grid_group grid = cg::this_grid();
  const int bid = blockIdx.x, nb = gridDim.x;
  int phase = 0;
#define PSYNC() do { ++phase; XcdBarrier xb_; xb_.bar = kparams().bar; xb_.x = xb_xcc_id(); xb_.st = (volatile LAS unsigned*)(smem + 70400); xcd_barrier(xb_); if (phase >= PHASE_LIMIT) return; } while (0)
  { const Params& p = kparams(); phase0(p, bid * 256 + tidx(), nb * 256);
    if (bid == 0) for (int i = threadIdx.x; i < XCD_BAR_WORDS; i += 256) __hip_atomic_store(p.bar + i, 0u, __ATOMIC_RELAXED, __HIP_MEMORY_SCOPE_AGENT); }
  if (threadIdx.x < 4) ((volatile unsigned*)(smem + 70400))[threadIdx.x] = 0u;
  grid.sync();
  (void)xcd_barrier_post(kparams().bar, (volatile LAS unsigned*)(smem + 70400));
  for (int layer = 0; layer < 4; ++layer) {
    const bool odd = layer & 1; const int li = layer >> 1;
    { const Params& p = kparams();
      const int ntn = (odd ? NPO : NPE) / 128;
      if ((nb & 7) == 0) {
        const int xcd = bid & 7, per = nb >> 3, tot = 32 * ntn;
        for (int j = bid >> 3; j < tot; j += per) {
          int mg = j / (8 * ntn), rem = j - mg * 8 * ntn, nt = rem >> 3, mi = rem & 7;
          inproj_task(p, layer, (xcd * 32 + mg * 8 + mi) * ntn + nt, smem);
        }
      } else {
        for (int t = bid; t < 256 * ntn; t += nb) inproj_task(p, layer, t, smem);
      }
      if (layer == 0) for (int t = bid; t < 256; t += nb) inproj_task(p, layer, 256 * ntn + t, smem);
    }
    PSYNC();
    if (!odd) {
      { const Params& p = kparams(); for (int t = bid; t < NPREP; t += nb) prep_task(p, li, t, smem); }
      PSYNC();
      { const Params& p = kparams(); for (int k = 0, t0 = bid; t0 < 2048 / MLA_NCT; ++k, t0 += nb) { int t = snake(k, t0, bid, nb, 2048 / MLA_NCT); __syncthreads(); mla_item(p, t, smem); } }
      { const Params& p = kparams(); for (int k = 0, t0 = bid; t0 < 2048; ++k, t0 += nb) { int t = snake(k, t0, bid, nb, 2048); __syncthreads(); nsa_item(p, t, smem); } }
      { const Params& p = kparams(); for (int t = bid; t < 1024 / MEM_NCT; t += nb) { __syncthreads(); mem_item(p, layer, t, smem); } }
      PSYNC();
    } else {
      { const Params& p = kparams();
        for (int t = bid; t < 2048 + 4096; t += nb) {
          __syncthreads();
          if (t < 2048) mlstm_x(p, li, t, smem); else dsa_select_item(p, t - 2048, smem);
        } }
      PSYNC();
      if (bid < 32) { const Params& p = kparams(); mlstm_y(p, bid); }
      if (bid >= 32) { const Params& p = kparams(); const int nb2 = nb - 32, b2 = bid - 32;
        for (int k = 0, t0 = b2; t0 < 2048 / DSA_NCT; ++k, t0 += nb2) { int t = snake(k, t0, b2, nb2, 2048 / DSA_NCT); __syncthreads(); dsa_item(p, t, smem); } }
      { const Params& p = kparams(); for (int t = bid; t < 1024 / MEM_NCT; t += nb) { __syncthreads(); mem_item(p, layer, t, smem); } }
      PSYNC();
      { const Params& p = kparams(); for (int t = bid; t < 2048; t += nb) { __syncthreads(); mlstm_z(p, li, t, smem); } }
      PSYNC();
    }
    { const Params& p = kparams();
      if ((nb & 7) == 0) {
        const int xcd = bid & 7, per = nb >> 3;
        for (int j = bid >> 3; j < 256; j += per) {
          int mg = j >> 6, rem = j & 63, nt = rem >> 3, mi = rem & 7;
          outproj_task(p, layer, (xcd * 32 + mg * 8 + mi) * 8 + nt, smem);
        }
      } else {
        for (int t = bid; t < 2048; t += nb) outproj_task(p, layer, t, smem);
      }
    }
    if (layer < 3) PSYNC();
  }
}

extern "C" void kernel_launch(void* const* d_in, const int* in_sizes, int n_in, void* d_out, int out_size, void* d_ws, size_t ws_size,
                              hipStream_t stream) {
  Params p{};
  const float* const* fin = (const float* const*)d_in;
  p.x = fin[0]; p.mem = fin[1]; p.pos = (const int*)d_in[2];
  p.ln_g = fin[3]; p.mem_norm_g = fin[4]; p.mem_w_kv = fin[5]; p.mem_q_g = fin[6]; p.mem_k_g = fin[7]; p.w_out = fin[8];
  p.even_w_in = fin[9]; p.mla_q_lat_g = fin[10]; p.mla_kv_lat_g = fin[11]; p.mla_w_uq = fin[12]; p.mla_w_ukv = fin[13];
  p.mla_q_norm_g = fin[14]; p.mla_k_norm_g = fin[15]; p.nsa_q_g = fin[16]; p.nsa_k_g = fin[17]; p.nsa_cmp_pos = fin[18];
  p.nsa_cmp_w1 = fin[19]; p.nsa_cmp_w2 = fin[20]; p.odd_w_in = fin[21]; p.dsa_q_g = fin[22]; p.dsa_k_g = fin[23];
  p.conv_w = fin[24]; p.conv_b = fin[25]; p.i_bias = fin[26]; p.f_bias = fin[27]; p.h_norm_g = fin[28];
  p.out = (float*)d_out;
  char* ws = (char*)d_ws; size_t off = 0;
  auto take = [&](size_t bytes) { char* r = ws + off; off += (bytes + 255) & ~(size_t)255; return r; };
  const size_t MB = 1u << 20;
  char* U = take(336 * MB);
  p.U = (bf16_t*)U; p.qbuf = (bf16_t*)(U + 208 * MB); p.xb = (bf16_t*)(U + 256 * MB); p.kbuf = (bf16_t*)(U + 256 * MB); p.vbuf = (bf16_t*)(U + 288 * MB);
  p.maskw = (unsigned*)(U + 256 * MB); p.mU = (float*)(U + 272 * MB);
  p.mix = (bf16_t*)take((size_t)T_ * 1280 * 2);
  for (int l = 0; l < 4; ++l) p.WinT[l] = (bf16_t*)take((size_t)((l & 1) ? NPO : NPE) * 1024 * 2);
  p.WoutT = (bf16_t*)take((size_t)4 * 1024 * 1280 * 2);
  p.WuqT = (bf16_t*)take((size_t)2 * 1024 * 256 * 2);
  p.WukvT = (bf16_t*)take((size_t)2 * 1024 * 128 * 2);
  p.WmemT = (bf16_t*)take((size_t)4 * 512 * 1024 * 2);
  p.Wc1T = (bf16_t*)take((size_t)4 * 64 * 2048 * 2);
  p.memb = (bf16_t*)take((size_t)NB * 256 * 1024 * 2);
  p.kcmp = (bf16_t*)take((size_t)NB * 256 * 128 * 2);
  p.vcmp = (bf16_t*)take((size_t)NB * 256 * 128 * 2);
  p.memk = (bf16_t*)take((size_t)4 * 2048 * 256 * 2);
  p.memv = (bf16_t*)take((size_t)4 * 2048 * 256 * 2);
  p.rope64 = (float*)take((size_t)T_ * 64 * 4);
  p.rope32 = (float*)take((size_t)T_ * 32 * 4);
  p.misc = (float*)take((size_t)T_ * 32 * 4);
  p.mN = (float*)take((size_t)2048 * 64 * 4);
  p.mS = (float*)take((size_t)2048 * 4 * 4);
  p.bar = (unsigned*)take(XCD_BAR_WORDS * 4);
  if (off > ws_size) { fprintf(stderr, "workspace too small: need %zu have %zu\n", off, ws_size); return; }
  static int grid_blocks = 0;
  if (!grid_blocks) {
    int dev = 0, cus = 0, per_cu = 0;
    (void)hipGetDevice(&dev);
    (void)hipDeviceGetAttribute(&cus, hipDeviceAttributeMultiprocessorCount, dev);
    (void)hipOccupancyMaxActiveBlocksPerMultiprocessor(&per_cu, mega, 256, 0);
    if (per_cu > 2) per_cu = 2;
    if (per_cu < 1) per_cu = 1;
    grid_blocks = cus * per_cu;
  }
  void* args[] = {&p};
  hipError_t e = hipLaunchCooperativeKernel((void*)mega, dim3(grid_blocks), dim3(256), args, 0, stream);
  if (e != hipSuccess) fprintf(stderr, "cooperative launch failed: %s (grid %d)\n", hipGetErrorString(e), grid_blocks);
}
```

```cpp
#include <hip/hip_runtime.h>
#include <hip/hip_cooperative_groups.h>
#include <cstdio>
namespace cg = cooperative_groups;

#define DI __device__ __forceinline__
typedef unsigned short bf16_t;
typedef short bf16x8 __attribute__((ext_vector_type(8)));
typedef short s16x4 __attribute__((ext_vector_type(4)));
typedef float f32x16 __attribute__((ext_vector_type(16)));
typedef float f32x4 __attribute__((ext_vector_type(4)));
typedef float f32x2 __attribute__((ext_vector_type(2)));
typedef __bf16 bfv2 __attribute__((ext_vector_type(2)));
typedef unsigned u32x4 __attribute__((ext_vector_type(4)));

#ifndef PHASE_LIMIT
#define PHASE_LIMIT 1000
#endif

constexpr int S_ = 4096, NB = 8, T_ = NB * S_, DM = 1024;
constexpr int NPE = 3328, NPO = 4096;
constexpr float EPS = 1e-6f;
constexpr float NEGF = -1e30f;
constexpr float LOG2E = 1.4426950408889634f;
constexpr float MFLOOR = -30000.f;
constexpr int E_AQL = 0, E_AKVL = 256, E_AKR = 384, E_AGATE = 448, E_BQ = 960, E_BKC = 1472, E_BVC = 1600, E_BKS = 1728,
              E_BVS = 1856, E_BKW = 1984, E_BVW = 2112, E_BGATE = 2240, E_MQ = 2752, E_MGATE = 3008;
constexpr int O_CQ = 0, O_CK = 512, O_CV = 576, O_CIQ = 640, O_CIK = 896, O_CGATE = 960, O_DQ = 1472, O_DK = 1728, O_DV = 1984,
              O_DO = 2496, O_DGATE = 3008, O_MQ = 3520, O_MGATE = 3776;
constexpr int SMEM_BYTES = 70656;

struct Params {
  const float *x, *mem; const int* pos;
  const float *ln_g, *mem_norm_g, *mem_w_kv, *mem_q_g, *mem_k_g, *w_out, *even_w_in, *mla_q_lat_g, *mla_kv_lat_g, *mla_w_uq,
      *mla_w_ukv, *mla_q_norm_g, *mla_k_norm_g, *nsa_q_g, *nsa_k_g, *nsa_cmp_pos, *nsa_cmp_w1, *nsa_cmp_w2, *odd_w_in, *dsa_q_g,
      *dsa_k_g, *conv_w, *conv_b, *i_bias, *f_bias, *h_norm_g;
  float* out;
  bf16_t *WinT[4], *WoutT, *WuqT, *WukvT, *WmemT, *Wc1T, *memb, *U, *xb, *qbuf, *kbuf, *vbuf, *mix, *kcmp, *vcmp, *memk, *memv;
  unsigned* maskw;
  float *rope64, *rope32, *misc, *mU, *mN, *mS;
  unsigned* bar;
};

DI int tidx() { int t = threadIdx.x; asm volatile("" : "+v"(t)); return t; }
DI float bf2f(bf16_t v) { return __uint_as_float(((unsigned)v) << 16); }
DI unsigned pk2(float a, float b) { f32x2 v = {a, b}; bfv2 r = __builtin_convertvector(v, bfv2); return __builtin_bit_cast(unsigned, r); }
DI bf16_t f2bf(float a) { return (bf16_t)(pk2(a, 0.f) & 0xffffu); }
DI float bflo(unsigned u) { return __uint_as_float(u << 16); }
DI float bfhi(unsigned u) { return __uint_as_float(u & 0xffff0000u); }
DI int crow(int i, int h) { return (i & 3) + 8 * (i >> 2) + 4 * h; }
DI float siluf(float x) { return x / (1.f + __expf(-x)); }
DI float sigmf(float x) { return 1.f / (1.f + __expf(-x)); }
DI float ex2(float x) { return __builtin_amdgcn_exp2f(x); }
DI f32x16 mfma32(bf16x8 a, bf16x8 b, f32x16 c) { return __builtin_amdgcn_mfma_f32_32x32x16_bf16(a, b, c, 0, 0, 0); }
typedef unsigned u32x2_ __attribute__((ext_vector_type(2)));
DI float xhalf_max(float x) { u32x2_ r = __builtin_amdgcn_permlane32_swap(__float_as_uint(x), __float_as_uint(x), false, false); return fmaxf(__uint_as_float(r[0]), __uint_as_float(r[1])); }
DI float xhalf_sum(float x) { u32x2_ r = __builtin_amdgcn_permlane32_swap(__float_as_uint(x), __float_as_uint(x), false, false); return __uint_as_float(r[0]) + __uint_as_float(r[1]); }
DI f32x16 zero16() { f32x16 z;
#pragma unroll
  for (int i = 0; i < 16; ++i) z[i] = 0.f; return z; }
DI bf16x8 pack8(const f32x16& x, int s) {
  u32x4 p; p.x = pk2(x[8 * s], x[8 * s + 1]); p.y = pk2(x[8 * s + 2], x[8 * s + 3]); p.z = pk2(x[8 * s + 4], x[8 * s + 5]); p.w = pk2(x[8 * s + 6], x[8 * s + 7]);
  return __builtin_bit_cast(bf16x8, p);
}
DI s16x4 trread(const bf16_t* p) {
  return __builtin_amdgcn_ds_read_tr16_b64_v4i16((s16x4 __attribute__((address_space(3)))*)(p));
}

DI int map_even(int n) { if (n < 416) return n; if (n < 448) return -1; if (n < 2240) return n - 32; if (n < 3264) return n - 8; if (n < 3288) return 2208 + (n - 3264); return -1; }
DI int map_odd(int n) { if (n < 928) return n; if (n < 960) return -1; if (n < 2496) return n - 24; if (n < 4032) return n - 16; if (n < 4040) return 928 + (n - 4032); if (n < 4048) return 2472 + (n - 4040); return -1; }
DI int map_uq(int n) { int h = n >> 7, c = n & 127; return c < 96 ? h * 96 + c : -1; }

template <int MAP>
DI void convT(bf16_t* dst, const float* src, const float* gain, int K, int Nsrc, int Npad, int gtid, int gsz) {
  int total = Npad * (K / 8);
  for (int i = gtid; i < total; i += gsz) {
    int n = (int)(i % Npad); int k0 = (int)(i / Npad) * 8;
    int sc = MAP == 0 ? n : MAP == 1 ? map_even(n) : MAP == 2 ? map_odd(n) : map_uq(n);
    u32x4 o = {0u, 0u, 0u, 0u};
    if (sc >= 0) {
      float v[8];
#pragma unroll
      for (int j = 0; j < 8; ++j) v[j] = src[(long)(k0 + j) * Nsrc + sc] * (gain ? gain[k0 + j] : 1.f);
      o.x = pk2(v[0], v[1]); o.y = pk2(v[2], v[3]); o.z = pk2(v[4], v[5]); o.w = pk2(v[6], v[7]);
    }
    *(u32x4*)(dst + (long)n * K + k0) = o;
  }
}

DI void cvt_rows(bf16_t* dst, const float* src, int n8, int gtid, int gsz) {
  for (int i = gtid; i < n8; i += gsz) {
    float4 a = ((const float4*)src)[2 * i], b = ((const float4*)src)[2 * i + 1];
    u32x4 o; o.x = pk2(a.x, a.y); o.y = pk2(a.z, a.w); o.z = pk2(b.x, b.y); o.w = pk2(b.z, b.w);
    ((u32x4*)dst)[i] = o;
  }
}

DI void phase0(const Params& p, int gtid, int gsz) {
  for (int l = 0; l < 4; ++l) {
    int li = l >> 1;
    if ((l & 1) == 0) convT<1>(p.WinT[l], p.even_w_in + (long)li * DM * 3256, p.ln_g + l * DM, DM, 3256, NPE, gtid, gsz);
    else convT<2>(p.WinT[l], p.odd_w_in + (long)li * DM * 4016, p.ln_g + l * DM, DM, 4016, NPO, gtid, gsz);
    convT<0>(p.WoutT + (long)l * 1024 * 1280, p.w_out + (long)l * 1280 * 1024, nullptr, 1280, 1024, 1024, gtid, gsz);
    convT<0>(p.WmemT + (long)l * 512 * 1024, p.mem_w_kv + (long)l * 1024 * 512, p.mem_norm_g + l * DM, 1024, 512, 512, gtid, gsz);
  }
  for (int li = 0; li < 2; ++li) {
    convT<3>(p.WuqT + (long)li * 1024 * 256, p.mla_w_uq + (long)li * 256 * 768, p.mla_q_lat_g + li * 256, 256, 768, 1024, gtid, gsz);
    convT<0>(p.WukvT + (long)li * 1024 * 128, p.mla_w_ukv + (long)li * 128 * 1024, p.mla_kv_lat_g + li * 128, 128, 1024, 1024, gtid, gsz);
    for (int kv = 0; kv < 2; ++kv)
      convT<0>(p.Wc1T + (long)(li * 2 + kv) * 64 * 2048, p.nsa_cmp_w1 + (long)(li * 2 + kv) * 2048 * 64, nullptr, 2048, 64, 64, gtid, gsz);
  }
  cvt_rows(p.xb, p.x, T_ * DM / 8, gtid, gsz);
  cvt_rows(p.memb, p.mem, NB * 256 * DM / 8, gtid, gsz);
  for (int i = gtid; i < T_ * 32; i += gsz) {
    int tok = (int)(i >> 5), f = (int)(i & 31);
    float ps = (float)p.pos[tok];
    float inv = powf(10000.f, -(float)f / 32.f);
    float ang = ps * inv;
    p.rope64[(long)i * 2] = cosf(ang); p.rope64[(long)i * 2 + 1] = sinf(ang);
    if (f < 16) {
      float inv2 = powf(10000.f, -(float)f / 16.f);
      float a2 = ps * inv2;
      p.rope32[((long)tok * 16 + f) * 2] = cosf(a2); p.rope32[((long)tok * 16 + f) * 2 + 1] = sinf(a2);
    }
  }
}

DI float sumsq8(u32x4 v) {
  float s = 0.f, t;
  t = bflo(v.x); s += t * t; t = bfhi(v.x); s += t * t; t = bflo(v.y); s += t * t; t = bfhi(v.y); s += t * t;
  t = bflo(v.z); s += t * t; t = bfhi(v.z); s += t * t; t = bflo(v.w); s += t * t; t = bfhi(v.w); s += t * t;
  return s;
}

template <bool ROWNORM, class Epi>
DI void gemm_tile(const bf16_t* __restrict__ A, int lda, const bf16_t* __restrict__ BT, int K, int m0, int n0, char* smem, Epi epi) {
  bf16_t* As = (bf16_t*)smem; bf16_t* Bs = As + 128 * 136;
  float* Cs = (float*)smem; float* rsc = (float*)(smem + 69632);
  const int tid = tidx(), lane = tid & 63, w = __builtin_amdgcn_readfirstlane(tid >> 6), wm = w >> 1, wn = w & 1, r = lane & 31, h = lane >> 5;
  const int lrow = tid >> 4, lkc = tid & 15;
  f32x16 acc[2][2];
#pragma unroll
  for (int i = 0; i < 2; ++i)
#pragma unroll
    for (int j = 0; j < 2; ++j) acc[i][j] = zero16();
  u32x4 ra[8], rb[8]; float ss[8] = {0.f, 0.f, 0.f, 0.f, 0.f, 0.f, 0.f, 0.f};
  const bf16_t* Ap = A + (long)(m0 + lrow) * lda + lkc * 8;
  const bf16_t* Bp = BT + (long)(n0 + lrow) * K + lkc * 8;
#pragma unroll
  for (int i = 0; i < 8; ++i) { ra[i] = *(const u32x4*)(Ap + (long)16 * i * lda); rb[i] = *(const u32x4*)(Bp + (long)16 * i * K); }
  const int nk = K >> 7;
  for (int kt = 0; kt < nk; ++kt) {
    __syncthreads();
#pragma unroll
    for (int i = 0; i < 8; ++i) {
      *(u32x4*)(As + (lrow + 16 * i) * 136 + lkc * 8) = ra[i];
      *(u32x4*)(Bs + (lrow + 16 * i) * 136 + lkc * 8) = rb[i];
      if (ROWNORM) ss[i] += sumsq8(ra[i]);
    }
    __syncthreads();
    if (kt + 1 < nk) {
#pragma unroll
      for (int i = 0; i < 8; ++i) { ra[i] = *(const u32x4*)(Ap + (long)16 * i * lda + (kt + 1) * 128); rb[i] = *(const u32x4*)(Bp + (long)16 * i * K + (kt + 1) * 128); }
    }
    {
      const bf16_t* Ar = As + (wm * 64 + r) * 136 + 8 * h;
      const bf16_t* Br = Bs + (wn * 64 + r) * 136 + 8 * h;
      bf16x8 fa[2][2], fb[2][2];
#pragma unroll
      for (int i = 0; i < 2; ++i) { fa[0][i] = *(const bf16x8*)(Ar + i * 32 * 136); fb[0][i] = *(const bf16x8*)(Br + i * 32 * 136); }
#pragma unroll
      for (int ks = 0; ks < 8; ++ks) {
        const int cu = ks & 1, nx = cu ^ 1;
        if (ks + 1 < 8) {
#pragma unroll
          for (int i = 0; i < 2; ++i) { fa[nx][i] = *(const bf16x8*)(Ar + i * 32 * 136 + (ks + 1) * 16); fb[nx][i] = *(const bf16x8*)(Br + i * 32 * 136 + (ks + 1) * 16); }
        }
#pragma unroll
        for (int i = 0; i < 2; ++i)
#pragma unroll
          for (int j = 0; j < 2; ++j) acc[i][j] = mfma32(fa[cu][i], fb[cu][j], acc[i][j]);
      }
    }
  }
  __syncthreads();
#pragma unroll
  for (int mi = 0; mi < 2; ++mi)
#pragma unroll
    for (int ni = 0; ni < 2; ++ni)
#pragma unroll
      for (int i = 0; i < 16; ++i) Cs[(wm * 64 + mi * 32 + crow(i, h)) * 132 + wn * 64 + ni * 32 + r] = acc[mi][ni][i];
  if (ROWNORM) {
#pragma unroll
    for (int i = 0; i < 8; ++i) {
      float sv = ss[i];
      sv += __shfl_xor(sv, 1); sv += __shfl_xor(sv, 2); sv += __shfl_xor(sv, 4); sv += __shfl_xor(sv, 8);
      if (lkc == 0) rsc[lrow + 16 * i] = rsqrtf(sv / (float)K + EPS);
    }
  }
  __syncthreads();
  {
    const int c8 = tid & 7, grp = (tid >> 3) & 1, rsub = tid >> 4;
    epi((n0 >> 6) + grp, c8, [&](auto body) {
#pragma unroll 2
      for (int pass = 0; pass < 8; ++pass) {
        int row = pass * 16 + rsub;
        body(m0 + row, Cs + row * 132 + grp * 64, ROWNORM ? rsc[row] : 1.f);
      }
    });
  }
}

DI void ld8(const float* p, float (&x)[8]) { *(float4*)&x[0] = ((const float4*)p)[0]; *(float4*)&x[4] = ((const float4*)p)[1]; }
DI void st8bf(bf16_t* dst, const float (&o)[8]) {
  u32x4 v; v.x = pk2(o[0], o[1]); v.y = pk2(o[2], o[3]); v.z = pk2(o[4], o[5]); v.w = pk2(o[6], o[7]);
  __builtin_nontemporal_store(v, (u32x4*)dst);
}
DI void ep_plain(const float* p, int c8, float sc, bf16_t* dst) {
  float x[8]; ld8(p + 8 * c8, x);
#pragma unroll
  for (int j = 0; j < 8; ++j) x[j] *= sc;
  st8bf(dst + 8 * c8, x);
}
DI void ep_zero(int c8, bf16_t* dst) { u32x4 z = {0u, 0u, 0u, 0u}; *(u32x4*)(dst + 8 * c8) = z; }
template <int HALF, bool NORM>
DI void ep_head(const float* p, int base, int lc, float rs, const float* g, const float* cs, bf16_t* dst) {
  constexpr int NL = HALF / 4;
  float x[8], xp[8], o[8];
  ld8(p + base + 8 * lc, x);
  const int pl = lc ^ (NL / 2);
  ld8(p + base + 8 * pl, xp);
  float sc = rs;
  if (NORM) {
    float ss = 0.f;
#pragma unroll
    for (int j = 0; j < 8; ++j) ss += x[j] * x[j];
#pragma unroll
    for (int d = 1; d < NL; d <<= 1) ss += __shfl_xor(ss, d);
    sc = rs * rsqrtf(ss * rs * rs * (1.f / (2 * HALF)) + EPS);
  }
  const bool lo = lc < NL / 2;
  const int i0 = 8 * (lc & (NL / 2 - 1));
#pragma unroll
  for (int j = 0; j < 8; ++j) {
    float xo = x[j] * sc, xq = xp[j] * sc;
    if (g) { xo *= g[8 * lc + j]; xq *= g[8 * pl + j]; }
    if (cs) {
      float co = cs[2 * (i0 + j)], si = cs[2 * (i0 + j) + 1];
      o[j] = lo ? (xo * co - xq * si) : (xq * si + xo * co);
    } else o[j] = xo;
  }
  st8bf(dst + base + 8 * lc, o);
}
DI void ep_norm64(const float* p, int c8, float rs, const float* g, const float* cs, bf16_t* dst) { ep_head<32, true>(p, 0, c8, rs, g, cs, dst); }

template <int NCT> struct FState { f32x16 o[NCT][2]; float m[NCT]; float l[NCT]; };
template <int NCT> DI void fs_init(FState<NCT>& st) {
#pragma unroll
  for (int a = 0; a < NCT; ++a) { st.m[a] = MFLOOR; st.l[a] = 0.f;
#pragma unroll
    for (int b = 0; b < 2; ++b) st.o[a][b] = zero16(); }
}
struct KVSrc { const bf16_t* k1; long ks1; const bf16_t* k2; long ks2; const bf16_t* v; long vs; };

template <int DQ>
DI void kv_load(const KVSrc& s, int key0, int nvalid, u32x4 (&kr)[DQ / 32], u32x4 (&vr)[2], int tid) {
  constexpr int CPR = DQ / 8;
#pragma unroll
  for (int i = 0; i < DQ / 32; ++i) {
    int c = tid + 256 * i; int row = c / CPR, cc = c % CPR; int key = key0 + row;
    u32x4 z = {0u, 0u, 0u, 0u};
    if (key < nvalid) {
      const bf16_t* ptr = (cc < 8) ? s.k1 + (long)key * s.ks1 + cc * 8 : s.k2 + (long)key * s.ks2 + (cc - 8) * 8;
      z = *(const u32x4*)ptr;
    }
    kr[i] = z;
  }
#pragma unroll
  for (int i = 0; i < 2; ++i) {
    int c = tid + 256 * i; int row = c >> 3, cc = c & 7; int key = key0 + row;
    u32x4 z = {0u, 0u, 0u, 0u};
    if (key < nvalid) z = *(const u32x4*)(s.v + (long)key * s.vs + cc * 8);
    vr[i] = z;
  }
}
template <int DQ>
DI void kv_store(bf16_t* Ks, bf16_t* Vs, const u32x4 (&kr)[DQ / 32], const u32x4 (&vr)[2], int tid) {
  constexpr int CPR = DQ / 8;
#pragma unroll
  for (int i = 0; i < DQ / 32; ++i) { int c = tid + 256 * i; int row = c / CPR, cc = c % CPR; *(u32x4*)(Ks + row * (DQ + 8) + cc * 8) = kr[i]; }
#pragma unroll
  for (int i = 0; i < 2; ++i) { int c = tid + 256 * i; int row = c >> 3, cc = c & 7; *(u32x4*)(Vs + row * 72 + cc * 8) = vr[i]; }
}

template <int DQ, bool MASKED, class MaskF>
DI void score_tile(const bf16_t* Ks, const bf16x8 (&qf)[DQ / 16], f32x16 (&s)[2], MaskF mask, int r, int h) {
#pragma unroll
  for (int sub = 0; sub < 2; ++sub) {
    f32x16 acc = zero16();
#pragma unroll
    for (int ks = 0; ks < DQ / 16; ++ks) {
      bf16x8 a = *(const bf16x8*)(Ks + (sub * 32 + r) * (DQ + 8) + ks * 16 + 8 * h);
      acc = mfma32(a, qf[ks], acc);
    }
    if (MASKED) {
#pragma unroll
      for (int i = 0; i < 16; ++i) acc[i] = mask(sub, i) ? acc[i] : NEGF;
    }
    s[sub] = acc;
  }
}

template <int DQ, int NCT, bool MASKED, class MaskF>
DI void flash_tile(const bf16_t* Ks, const bf16_t* Vs, const bf16x8 (&qf)[NCT][DQ / 16], FState<NCT>& st, float sc2, MaskF mask, int lane) {
  const int r = lane & 31, h = lane >> 5;
  const int q4 = (lane & 15) >> 2, pp = lane & 3, blk = (lane >> 4) & 1;
#pragma unroll
  for (int ct = 0; ct < NCT; ++ct) {
    bf16x8 pf[4];
    {
      f32x16 s[2];
      score_tile<DQ, MASKED>(Ks, qf[ct], s, [&](int sub, int i) { return mask(ct, sub, i); }, r, h);
      float mx = NEGF;
#pragma unroll
      for (int sub = 0; sub < 2; ++sub)
#pragma unroll
        for (int i = 0; i < 16; ++i) mx = fmaxf(mx, s[sub][i]);
      mx = xhalf_max(mx);
      float mnew = fmaxf(st.m[ct], mx * sc2);
      float alpha = ex2(st.m[ct] - mnew);
      st.m[ct] = mnew;
      float rs = 0.f;
#pragma unroll
      for (int sub = 0; sub < 2; ++sub)
#pragma unroll
        for (int i = 0; i < 16; ++i) { float pv = ex2(fmaf(s[sub][i], sc2, -mnew)); s[sub][i] = pv; rs += pv; }
      rs = xhalf_sum(rs);
      st.l[ct] = st.l[ct] * alpha + rs;
      if (__ballot(alpha != 1.f) != 0ull) {
#pragma unroll
        for (int d = 0; d < 2; ++d)
#pragma unroll
          for (int i = 0; i < 16; ++i) st.o[ct][d][i] *= alpha;
      }
#pragma unroll
      for (int sub = 0; sub < 2; ++sub)
#pragma unroll
        for (int s2 = 0; s2 < 2; ++s2) pf[sub * 2 + s2] = pack8(s[sub], s2);
    }
#pragma unroll
    for (int dvt = 0; dvt < 2; ++dvt)
#pragma unroll
      for (int f = 0; f < 4; ++f) {
        int keybase = (f >> 1) * 32 + (f & 1) * 16 + 4 * h;
        const bf16_t* vp = Vs + (keybase + q4) * 72 + dvt * 32 + 16 * blk + 4 * pp;
        s16x4 lo = trread(vp), hi = trread(vp + 8 * 72);
        bf16x8 vf = __builtin_shufflevector(lo, hi, 0, 1, 2, 3, 4, 5, 6, 7);
        st.o[ct][dvt] = mfma32(vf, pf[f], st.o[ct][dvt]);
      }
  }
}

DI void write_out(const f32x16 (&o)[2], float inv, const bf16_t* gate, bf16_t* dst, int h) {
#pragma unroll
  for (int dvt = 0; dvt < 2; ++dvt)
#pragma unroll
    for (int g4 = 0; g4 < 4; ++g4) {
      int dv = dvt * 32 + 8 * g4 + 4 * h;
      uint2 gv = *(const uint2*)(gate + dv);
      float y0 = o[dvt][4 * g4] * inv * siluf(bflo(gv.x)), y1 = o[dvt][4 * g4 + 1] * inv * siluf(bfhi(gv.x));
      float y2 = o[dvt][4 * g4 + 2] * inv * siluf(bflo(gv.y)), y3 = o[dvt][4 * g4 + 3] * inv * siluf(bfhi(gv.y));
      uint2 ov; ov.x = pk2(y0, y1); ov.y = pk2(y2, y3);
      *(uint2*)(dst + dv) = ov;
    }
}

template <int DQ>
DI void load_q(bf16x8 (&qf)[DQ / 16], const bf16_t* qrow, int h) {
#pragma unroll
  for (int ks = 0; ks < DQ / 16; ++ks) qf[ks] = *(const bf16x8*)(qrow + ks * 16 + 8 * h);
}

template <int DQ, int NCT, bool DB = false, class MaskF, class NeedF>
DI void attn_pass(const KVSrc& src, int kt0, int kt1, int nvalid, const bf16x8 (&qf)[NCT][DQ / 16], FState<NCT>& st, float sc2, MaskF mask, NeedF need, char* smem) {
  const int tid = tidx(), lane = tid & 63;
  u32x4 kr[DQ / 32], vr[2];
  if (!DB) {
    bf16_t* Ks = (bf16_t*)smem; bf16_t* Vs = (bf16_t*)(smem + 13312);
    if (kt0 < kt1) kv_load<DQ>(src, kt0 * 64, nvalid, kr, vr, tid);
    for (int kt = kt0; kt < kt1; ++kt) {
      __syncthreads();
      kv_store<DQ>(Ks, Vs, kr, vr, tid);
      __syncthreads();
      if (kt + 1 < kt1) kv_load<DQ>(src, (kt + 1) * 64, nvalid, kr, vr, tid);
      const int nd = need(kt);
      if (nd == 1) flash_tile<DQ, NCT, false>(Ks, Vs, qf, st, sc2, [&](int ct, int sub, int i) { return true; }, lane);
      else if (nd == 2) flash_tile<DQ, NCT, true>(Ks, Vs, qf, st, sc2, [&](int ct, int sub, int i) { return mask(kt, ct, sub, i); }, lane);
    }
  } else {
    if (kt0 >= kt1) return;
    kv_load<DQ>(src, kt0 * 64, nvalid, kr, vr, tid);
    __syncthreads();
    kv_store<DQ>((bf16_t*)smem, (bf16_t*)(smem + 13312), kr, vr, tid);
    __syncthreads();
    int cur = 0;
    for (int kt = kt0; kt < kt1; ++kt) {
      bf16_t* Ks = (bf16_t*)(smem + cur * 22528); bf16_t* Vs = (bf16_t*)(smem + cur * 22528 + 13312);
      const bool more = kt + 1 < kt1;
      if (more) kv_load<DQ>(src, (kt + 1) * 64, nvalid, kr, vr, tid);
      const int nd = need(kt);
      if (nd == 1) flash_tile<DQ, NCT, false>(Ks, Vs, qf, st, sc2, [&](int ct, int sub, int i) { return true; }, lane);
      else if (nd == 2) flash_tile<DQ, NCT, true>(Ks, Vs, qf, st, sc2, [&](int ct, int sub, int i) { return mask(kt, ct, sub, i); }, lane);
      if (more) kv_store<DQ>((bf16_t*)(smem + (cur ^ 1) * 22528), (bf16_t*)(smem + (cur ^ 1) * 22528 + 13312), kr, vr, tid);
      __syncthreads();
      cur ^= 1;
    }
  }
}

#ifndef MLA_NCT
#define MLA_NCT 1
#endif
#ifndef MEM_NCT
#define MEM_NCT 2
#endif
#ifndef DSA_NCT
#define DSA_NCT 2
#endif
DI void mla_item(const Params& p, int item, char* smem) {
  constexpr int NCT = MLA_NCT, NQB = 32 / NCT;
  const int qb = NQB - 1 - (item >> 6), bh = item & 63, b = bh >> 3, hd = bh & 7;
  const int tid = tidx(), lane = tid & 63, w = __builtin_amdgcn_readfirstlane(tid >> 6), r = lane & 31, h = lane >> 5;
  const int q0 = qb * 128 * NCT;
  int tq[NCT]; bf16x8 qf[NCT][6];
#pragma unroll
  for (int ct = 0; ct < NCT; ++ct) { tq[ct] = q0 + (w * NCT + ct) * 32 + r; load_q<96>(qf[ct], p.qbuf + ((long)b * S_ + tq[ct]) * 768 + hd * 96, h); }
  KVSrc src; src.k1 = p.kbuf + (long)b * S_ * 512 + hd * 64; src.ks1 = 512; src.k2 = p.U + (long)b * S_ * NPE + E_AKR; src.ks2 = NPE;
  src.v = p.vbuf + (long)b * S_ * 512 + hd * 64; src.vs = 512;
  FState<NCT> st; fs_init(st);
  const int wminq = q0 + w * NCT * 32, wmaxq = wminq + NCT * 32 - 1;
  const float sc2 = 0.10206207261596575f * LOG2E;
  attn_pass<96, NCT, true>(src, 0, (q0 + 128 * NCT) / 64, S_, qf, st, sc2,
                     [&](int kt, int ct, int sub, int i) { return kt * 64 + sub * 32 + crow(i, h) <= tq[ct]; },
                     [&](int kt) { return kt * 64 > wmaxq ? 0 : (kt * 64 + 63 <= wminq ? 1 : 2); }, smem);
#pragma unroll
  for (int ct = 0; ct < NCT; ++ct) {
    const long tok = (long)b * S_ + tq[ct];
    float inv = st.l[ct] > 0.f ? 1.f / st.l[ct] : 0.f;
    write_out(st.o[ct], inv, p.U + tok * NPE + E_AGATE + hd * 64, p.mix + tok * 1280 + hd * 64, h);
  }
}

DI void mem_item(const Params& p, int layer, int item, char* smem) {
  constexpr int NCT = MEM_NCT;
  const bool odd = layer & 1; const int NP = odd ? NPO : NPE, cq = odd ? O_MQ : E_MQ, cg_ = odd ? O_MGATE : E_MGATE;
  const int qb = item >> 5, bh = item & 31, b = bh >> 2, hd = bh & 3;
  const int tid = tidx(), lane = tid & 63, w = __builtin_amdgcn_readfirstlane(tid >> 6), r = lane & 31, h = lane >> 5;
  int tq[NCT]; bf16x8 qf[NCT][4];
#pragma unroll
  for (int ct = 0; ct < NCT; ++ct) { tq[ct] = qb * 128 * NCT + (w * NCT + ct) * 32 + r; load_q<64>(qf[ct], p.U + ((long)b * S_ + tq[ct]) * NP + cq + hd * 64, h); }
  KVSrc src; src.k1 = p.memk + ((long)(layer * NB + b) * 256) * 256 + hd * 64; src.ks1 = 256; src.k2 = src.k1; src.ks2 = 0;
  src.v = p.memv + ((long)(layer * NB + b) * 256) * 256 + hd * 64; src.vs = 256;
  FState<NCT> st; fs_init(st);
  attn_pass<64, NCT, true>(src, 0, 4, 256, qf, st, 0.125f * LOG2E, [&](int, int, int, int) { return true; }, [&](int) { return 1; }, smem);
#pragma unroll
  for (int ct = 0; ct < NCT; ++ct) {
    const long tok = (long)b * S_ + tq[ct];
    float inv = st.l[ct] > 0.f ? 1.f / st.l[ct] : 0.f;
    write_out(st.o[ct], inv, p.U + tok * NP + cg_ + hd * 64, p.mix + tok * 1280 + 1024 + hd * 64, h);
  }
}

DI void dsa_item(const Params& p, int item, char* smem) {
  constexpr int NCT = DSA_NCT, NQB = 256 / NCT;
  const int qb = NQB - 1 - (item >> 3), b = item & 7;
  const int tid = tidx(), lane = tid & 63, w = __builtin_amdgcn_readfirstlane(tid >> 6), r = lane & 31, h = lane >> 5;
  const int q0 = qb * 16 * NCT;
  int tq[NCT]; bf16x8 qf[NCT][4];
  const int hd = r & 7;
  const unsigned* mwb = p.maskw + (long)b * S_ * 128;
#pragma unroll
  for (int ct = 0; ct < NCT; ++ct) {
    tq[ct] = q0 + (w * NCT + ct) * 4 + (r >> 3);
    const long tok = (long)b * S_ + tq[ct];
    load_q<64>(qf[ct], p.U + tok * NPO + O_CQ + hd * 64, h);
  }
  KVSrc src; src.k1 = p.U + (long)b * S_ * NPO + O_CK; src.ks1 = NPO; src.k2 = src.k1; src.ks2 = 0; src.v = p.U + (long)b * S_ * NPO + O_CV; src.vs = NPO;
  FState<NCT> st; fs_init(st);
  attn_pass<64, NCT, false>(src, 0, (q0 + 16 * NCT - 1) / 64 + 1, S_, qf, st, 0.125f * LOG2E,
                     [&](int kt, int ct, int sub, int i) { unsigned wd = mwb[tq[ct] * 128 + kt * 2 + sub]; return ((wd >> crow(i, h)) & 1u) != 0u; },
                     [&](int) { return 2; }, smem);
#pragma unroll
  for (int ct = 0; ct < NCT; ++ct) {
    const long tok = (long)b * S_ + tq[ct];
    float inv = st.l[ct] > 0.f ? 1.f / st.l[ct] : 0.f;
    write_out(st.o[ct], inv, p.U + tok * NPO + O_CGATE + hd * 64, p.mix + tok * 1280 + hd * 64, h);
  }
}

DI void nsa_item(const Params& p, int item, char* smem) {
  const int qb = 127 - (item >> 4), bg = item & 15, b = bg >> 1, g = bg & 1;
  const int tid = tidx(), lane = tid & 63, w = __builtin_amdgcn_readfirstlane(tid >> 6), r = lane & 31, h = lane >> 5;
  const int q0 = qb * 32, cur = q0 >> 6;
  bf16_t* Ks = (bf16_t*)smem; bf16_t* Vs = (bf16_t*)(smem + 13312);
  float* imp = (float*)(smem + 22528);
  unsigned long long* selm = (unsigned long long*)(smem + 30720);
  unsigned long long* uni = (unsigned long long*)(smem + 30976);
  const int ql = w * 8 + (r >> 2), tq = q0 + ql, hd = g * 4 + (r & 3);
  const long tok = (long)b * S_ + tq;
  bf16x8 qf[1][4];
  load_q<64>(qf[0], p.U + tok * NPE + E_BQ + hd * 64, h);
  const float sc2 = 0.125f * LOG2E;
  float* oaccL = (float*)(smem + 32768) + tid;
  const float* gatep = p.misc + tok * 32 + hd * 3;
  for (int i = tid; i < 32 * 64; i += 256) imp[i] = 0.f;

  KVSrc csrc; csrc.k1 = p.kcmp + (long)b * 256 * 128 + g * 64; csrc.ks1 = 128; csrc.k2 = csrc.k1; csrc.ks2 = 0; csrc.v = p.vcmp + (long)b * 256 * 128 + g * 64; csrc.vs = 128;
  const int nmax = q0 >> 4;
  const int nct = (nmax >> 6) + 1;
  FState<1> st; fs_init(st);
  auto cmask = [&](int kt, int sub, int i) { int n = kt * 64 + sub * 32 + crow(i, h); return 16 * n + 31 <= tq; };
  attn_pass<64, 1>(csrc, 0, nct, 255, qf, st, sc2, [&](int kt, int, int sub, int i) { return cmask(kt, sub, i); }, [&](int) { return 2; }, smem);
  const float linv = st.l[0] > 0.f ? 1.f / st.l[0] : 0.f;
  const float mfin = st.m[0];
  const float g0l = sigmf(gatep[0]) * linv;
#pragma unroll
  for (int d = 0; d < 2; ++d)
#pragma unroll
    for (int i = 0; i < 16; ++i) oaccL[(d * 16 + i) * 256] = g0l * st.o[0][d][i];
  {
    u32x4 kr[2], vr[2];
    float carry = 0.f;
    for (int kt = 0; kt < nct; ++kt) {
      __syncthreads();
      kv_load<64>(csrc, kt * 64, 255, kr, vr, tid);
      kv_store<64>(Ks, Vs, kr, vr, tid);
      __syncthreads();
      f32x16 s[2];
      score_tile<64, true>(Ks, qf[0], s, [&](int sub, int i) { return cmask(kt, sub, i); }, r, h);
#pragma unroll
      for (int sub = 0; sub < 2; ++sub) {
        float pr[16];
#pragma unroll
        for (int i = 0; i < 16; ++i) pr[i] = ex2(fmaf(s[sub][i], sc2, -mfin)) * linv;
        float part[4];
#pragma unroll
        for (int g4 = 0; g4 < 4; ++g4) part[g4] = __shfl_xor(pr[4 * g4 + 3], 32);
#pragma unroll
        for (int g4 = 0; g4 < 4; ++g4) {
          float gs = pr[4 * g4] + pr[4 * g4 + 1] + pr[4 * g4 + 2] + pr[4 * g4 + 3];
          float ex = h ? part[g4] : (g4 > 0 ? part[g4 - 1] : carry);
          float v = gs + ex;
          v += __shfl_xor(v, 1); v += __shfl_xor(v, 2);
          int j = kt * 16 + sub * 8 + 2 * g4 + h;
          if ((r & 3) == 0) imp[ql * 64 + j] = v;
        }
        carry = part[3];
      }
    }
  }
  __syncthreads();
  {
    unsigned long long wun = 0ull;
    for (int qi = 0; qi < 8; ++qi) {
      int qq = w * 8 + qi; int t = q0 + qq;
      int j = lane;
      float forced = (j == cur) ? 3e4f : ((j == cur - 1) ? 2e4f : ((j == 0) ? 1e4f : 0.f));
      float sc = (64 * j <= t) ? imp[qq * 64 + j] + forced : NEGF;
      int rank = 0;
#pragma unroll
      for (int i = 0; i < 64; ++i) {
        float si = __uint_as_float(__builtin_amdgcn_readlane(__float_as_uint(sc), i));
        rank += (si > sc || (si == sc && i < j)) ? 1 : 0;
      }
      unsigned long long m = __ballot(rank < 16 && 64 * j <= t);
      if (lane == 0) selm[qq] = m;
      wun |= m;
    }
    if (lane == 0) uni[w] = wun;
  }
  __syncthreads();
  const unsigned long long un = uni[0] | uni[1] | uni[2] | uni[3];
  const unsigned long long sm = selm[ql];
  {
    KVSrc ssrc; ssrc.k1 = p.U + (long)b * S_ * NPE + E_BKS + g * 64; ssrc.ks1 = NPE; ssrc.k2 = ssrc.k1; ssrc.ks2 = 0; ssrc.v = p.U + (long)b * S_ * NPE + E_BVS + g * 64; ssrc.vs = NPE;
    fs_init(st);
    u32x4 kr[2], vr[2];
    unsigned long long rem = un;
    int j = rem ? __builtin_ctzll(rem) : -1;
    if (j >= 0) kv_load<64>(ssrc, j * 64, S_, kr, vr, tid);
    while (j >= 0) {
      rem &= rem - 1;
      int jn = rem ? __builtin_ctzll(rem) : -1;
      __syncthreads();
      kv_store<64>(Ks, Vs, kr, vr, tid);
      __syncthreads();
      if (jn >= 0) kv_load<64>(ssrc, jn * 64, S_, kr, vr, tid);
      bool b0 = (sm >> j) & 1ull;
      if (__ballot(b0) != 0ull)
        flash_tile<64, 1, true>(Ks, Vs, qf, st, sc2, [&](int, int sub, int i) { return b0 && (j * 64 + sub * 32 + crow(i, h) <= tq); }, lane);
      j = jn;
    }
    float li = (st.l[0] > 0.f ? 1.f / st.l[0] : 0.f) * sigmf(gatep[1]);
#pragma unroll
    for (int d = 0; d < 2; ++d)
#pragma unroll
      for (int i = 0; i < 16; ++i) oaccL[(d * 16 + i) * 256] += li * st.o[0][d][i];
  }
  {
    KVSrc wsrc; wsrc.k1 = p.U + (long)b * S_ * NPE + E_BKW + g * 64; wsrc.ks1 = NPE; wsrc.k2 = wsrc.k1; wsrc.ks2 = 0; wsrc.v = p.U + (long)b * S_ * NPE + E_BVW + g * 64; wsrc.vs = NPE;
    fs_init(st);
    int kt0 = q0 - 511 < 0 ? 0 : (q0 - 511) >> 6;
    attn_pass<64, 1>(wsrc, kt0, cur + 1, S_, qf, st, sc2,
                     [&](int kt, int, int sub, int i) { int key = kt * 64 + sub * 32 + crow(i, h); return key <= tq && key > tq - 512; },
                     [&](int kt) { return (kt * 64 + 63 <= q0 + w * 8 && kt * 64 > q0 + w * 8 + 7 - 512) ? 1 : 2; }, smem);
    float li = (st.l[0] > 0.f ? 1.f / st.l[0] : 0.f) * sigmf(gatep[2]);
#pragma unroll
    for (int d = 0; d < 2; ++d)
#pragma unroll
      for (int i = 0; i < 16; ++i) st.o[0][d][i] = oaccL[(d * 16 + i) * 256] + li * st.o[0][d][i];
  }
  write_out(st.o[0], 1.f, p.U + tok * NPE + E_BGATE + hd * 64, p.mix + tok * 1280 + 512 + hd * 64, h);
  __syncthreads();
}

DI void cmp_item(const Params& p, int li, int item, char* smem) {
  const int kv = item & 1, tile = item >> 1;
  const int tid = tidx(), lane = tid & 63, w = __builtin_amdgcn_readfirstlane(tid >> 6), r = lane & 31, h = lane >> 5;
  float* part = (float*)smem;
  float* h1 = (float*)(smem + 33280);
  float* o2 = (float*)(smem + 41600);
  const int idx = tile * 32 + r;
  const bool rv = idx < NB * 255 * 2;
  const int bb = rv ? idx / 510 : 0, rem = rv ? idx % 510 : 0, n = rem >> 1, g = rem & 1;
  const bf16_t* arow = p.U + ((long)(bb * S_ + 16 * n)) * NPE + (kv ? E_BVC : E_BKC) + g * 64;
  const float* pe = p.nsa_cmp_pos + (long)(li * 2 + kv) * 32 * 64;
  const bf16_t* W1 = p.Wc1T + (long)(li * 2 + kv) * 64 * 2048;
  f32x16 acc[2] = {zero16(), zero16()};
  for (int ks_ = 0; ks_ < 32; ++ks_) {
    int ks = ks_; asm volatile("" : "+s"(ks));
    int k = w * 512 + ks * 16 + 8 * h; int l = k >> 6, d = k & 63;
    u32x4 av = *(const u32x4*)(arow + (long)l * NPE + d);
    float4 pa = *(const float4*)(pe + l * 64 + d), pb = *(const float4*)(pe + l * 64 + d + 4);
    u32x4 af;
    af.x = pk2(bflo(av.x) + pa.x, bfhi(av.x) + pa.y); af.y = pk2(bflo(av.y) + pa.z, bfhi(av.y) + pa.w);
    af.z = pk2(bflo(av.z) + pb.x, bfhi(av.z) + pb.y); af.w = pk2(bflo(av.w) + pb.z, bfhi(av.w) + pb.w);
    bf16x8 a = __builtin_bit_cast(bf16x8, af);
#pragma unroll
    for (int nt = 0; nt < 2; ++nt) {
      bf16x8 bfr = *(const bf16x8*)(W1 + (long)(nt * 32 + r) * 2048 + k);
      acc[nt] = mfma32(a, bfr, acc[nt]);
    }
  }
  __syncthreads();
#pragma unroll
  for (int nt = 0; nt < 2; ++nt)
#pragma unroll
    for (int i = 0; i < 16; ++i) part[(w * 32 + crow(i, h)) * 65 + nt * 32 + r] = acc[nt][i];
  __syncthreads();
  for (int e = tid; e < 32 * 64; e += 256) {
    int rr = e >> 6, cc = e & 63;
    float v = part[rr * 65 + cc] + part[(32 + rr) * 65 + cc] + part[(64 + rr) * 65 + cc] + part[(96 + rr) * 65 + cc];
    h1[rr * 65 + cc] = siluf(v);
  }
  __syncthreads();
  {
    const float* W2 = p.nsa_cmp_w2 + (long)(li * 2 + kv) * 64 * 64;
    int rr = tid >> 3, c0 = (tid & 7) * 8;
    float o[8] = {0.f, 0.f, 0.f, 0.f, 0.f, 0.f, 0.f, 0.f};
    for (int i = 0; i < 64; ++i) {
      float hv = h1[rr * 65 + i];
      float4 wa = *(const float4*)(W2 + i * 64 + c0), wb = *(const float4*)(W2 + i * 64 + c0 + 4);
      o[0] += hv * wa.x; o[1] += hv * wa.y; o[2] += hv * wa.z; o[3] += hv * wa.w;
      o[4] += hv * wb.x; o[5] += hv * wb.y; o[6] += hv * wb.z; o[7] += hv * wb.w;
    }
#pragma unroll
    for (int j = 0; j < 8; ++j) o2[rr * 65 + c0 + j] = o[j];
  }
  __syncthreads();
  if (tid < 32) {
    int idx2 = tile * 32 + tid;
    if (idx2 < NB * 255 * 2) {
      int b2 = idx2 / 510, rem2 = idx2 % 510, n2 = rem2 >> 1, g2 = rem2 & 1;
      const float* row = o2 + tid * 65;
      bf16_t* dst = (kv ? p.vcmp : p.kcmp) + ((long)(b2 * 256 + n2)) * 128 + g2 * 64;
      if (kv) {
#pragma unroll 4
        for (int i = 0; i < 64; ++i) dst[i] = f2bf(row[i]);
      } else {
        float ss = 0.f;
#pragma unroll 4
        for (int i = 0; i < 64; ++i) ss += row[i] * row[i];
        float sc = rsqrtf(ss * (1.f / 64.f) + EPS);
        const float* gn = p.nsa_k_g + li * 192;
        const float* cs = p.rope64 + ((long)(b2 * S_ + 16 * n2 + 31)) * 64;
#pragma unroll 2
        for (int i = 0; i < 32; ++i) {
          float x1 = row[i] * sc * gn[i], x2 = row[i + 32] * sc * gn[i + 32];
          float co = cs[2 * i], si = cs[2 * i + 1];
          dst[i] = f2bf(x1 * co - x2 * si); dst[i + 32] = f2bf(x1 * si + x2 * co);
        }
      }
    }
  }
  __syncthreads();
}

DI unsigned mono(float f) { unsigned u = __float_as_uint(f); return (u & 0x80000000u) ? ~u : (u | 0x80000000u); }
DI int red32(int v) {
  v += __builtin_amdgcn_update_dpp(0, v, 0xB1, 0xF, 0xF, true);
  v += __builtin_amdgcn_update_dpp(0, v, 0x4E, 0xF, 0xF, true);
  v += __builtin_amdgcn_update_dpp(0, v, 0x141, 0xF, 0xF, true);
  v += __builtin_amdgcn_update_dpp(0, v, 0x140, 0xF, 0xF, true);
  v += __shfl_xor(v, 16);
  return v;
}

DI void dsa_select_item(const Params& p, int item, char* smem) {
  const int idx_ = item >> 3, zk_ = idx_ >> 6, zj_ = idx_ & 63;
  const int b = item & 7, q8 = 511 - ((zk_ & 1) ? (zk_ * 64 + 63 - zj_) : idx_);
  const int tid_ = tidx();
  const int lane = tid_ & 63, w = __builtin_amdgcn_readfirstlane(tid_ >> 6);
  const int hq = lane >> 5, l16 = lane & 15, g16 = lane >> 4, bit = g16 & 1;
  const int tqa = q8 * 8 + 2 * w, tq = tqa + hq, tqb = tqa + 1;
  const long tokb = (long)b * S_;
  bf16x8 af = *(const bf16x8*)(p.U + (tokb + tqa + (l16 >> 3)) * NPO + O_CIQ + (l16 & 7) * 32 + 8 * g16);
  float iw[4];
#pragma unroll
  for (int j = 0; j < 4; ++j) iw[j] = p.misc[(tokb + tq) * 32 + bit * 4 + j] * 0.35355339059327373f;
  unsigned ku[64];
  unsigned* kl = (unsigned*)smem + w * 4096 + lane;
  const int imax = tqb >> 5;
  const char* ikb = (const char*)(p.U + tokb * NPO + O_CIK);
  const unsigned voff = (unsigned)(l16 * NPO + 8 * g16) * 2u;
  auto score = [&](int i) -> unsigned {
    const char* sb = ikb + (size_t)i * (32 * NPO * 2);
    bf16x8 b0 = *(const bf16x8*)(sb + voff);
    bf16x8 b1 = *(const bf16x8*)(sb + 16 * NPO * 2 + voff);
    f32x4 z = {0.f, 0.f, 0.f, 0.f};
    f32x4 c0 = __builtin_amdgcn_mfma_f32_16x16x32_bf16(af, b0, z, 0, 0, 0);
    f32x4 c1 = __builtin_amdgcn_mfma_f32_16x16x32_bf16(af, b1, z, 0, 0, 0);
    float sA = iw[0] * fmaxf(c0[0], 0.f) + iw[1] * fmaxf(c0[1], 0.f) + iw[2] * fmaxf(c0[2], 0.f) + iw[3] * fmaxf(c0[3], 0.f);
    float sB = iw[0] * fmaxf(c1[0], 0.f) + iw[1] * fmaxf(c1[1], 0.f) + iw[2] * fmaxf(c1[2], 0.f) + iw[3] * fmaxf(c1[3], 0.f);
    float keep = bit ? sB : sA, send = bit ? sA : sB;
    float sc = keep + __shfl_xor(send, 16);
    int key = 32 * i + (lane & 31);
    return mono(key <= tq ? sc : NEGF);
  };
#pragma unroll
  for (int c = 0; c < 8; ++c) {
    if (8 * c <= imax) {
#pragma unroll
      for (int j = 0; j < 8; ++j) ku[8 * c + j] = score(8 * c + j);
    } else {
#pragma unroll
      for (int j = 0; j < 8; ++j) ku[8 * c + j] = 0u;
    }
  }
  const int iend = imax < 64 ? 63 : (imax | 3);
  for (int i = 64; i <= iend; i += 4) {
    unsigned k0 = score(i), k1 = score(i + 1), k2 = score(i + 2), k3 = score(i + 3);
    kl[(i - 64) * 64] = k0; kl[(i - 63) * 64] = k1; kl[(i - 62) * 64] = k2; kl[(i - 61) * 64] = k3;
  }
  unsigned thr = 0u; int need = 1 << 20;
  unsigned* mw = p.maskw + (tokb + tq) * 128;
  const unsigned lowmask = (1u << (lane & 31)) - 1u;
  int run = 0;
  auto emit = [&](int i, unsigned kv) {
    bool eq = kv == thr, gt = kv > thr;
    unsigned long long bal = __ballot(eq);
    unsigned mine = hq ? (unsigned)(bal >> 32) : (unsigned)bal;
    int pre = __popc(mine & lowmask);
    bool sel = gt || (eq && (run + pre < need));
    run += __popc(mine);
    sel = sel && (32 * i + (lane & 31) <= tq);
    unsigned long long sb = __ballot(sel);
    unsigned word = hq ? (unsigned)(sb >> 32) : (unsigned)sb;
    if ((lane & 31) == 0) mw[i] = word;
  };
  if (imax < 64) {
    if (tqa >= 256) {
      bool done = false;
      for (int bt = 31; bt >= 0; --bt) {
        unsigned cand = thr | (1u << bt);
        int cnt = 0;
#pragma unroll
        for (int i = 0; i < 64; ++i) cnt += (ku[i] >= cand) ? 1 : 0;
        cnt = red32(cnt);
        if (!done) { thr = cnt >= 256 ? cand : thr; done = (cnt == 256); }
        if (__all(done)) break;
      }
      int cg = 0;
#pragma unroll
      for (int i = 0; i < 64; ++i) cg += (ku[i] > thr) ? 1 : 0;
      need = 256 - red32(cg);
    }
#pragma unroll
    for (int i = 0; i < 64; ++i) emit(i, ku[i]);
    for (int i = 64; i < 128; ++i) { if ((lane & 31) == 0) mw[i] = 0u; }
  } else {
    unsigned k2[64];
#pragma unroll
    for (int j = 0; j < 64; ++j) { unsigned v = kl[j * 64]; k2[j] = (64 + j <= iend) ? v : 0u; }
    bool done = false;
    for (int bt = 31; bt >= 0; --bt) {
      unsigned cand = thr | (1u << bt);
      int cnt = 0;
#pragma unroll
      for (int i = 0; i < 64; ++i) cnt += ((ku[i] >= cand) ? 1 : 0) + ((k2[i] >= cand) ? 1 : 0);
      cnt = red32(cnt);
      if (!done) { thr = cnt >= 256 ? cand : thr; done = (cnt == 256); }
      if (__all(done)) break;
    }
    int cg = 0;
#pragma unroll
    for (int i = 0; i < 64; ++i) cg += ((ku[i] > thr) ? 1 : 0) + ((k2[i] > thr) ? 1 : 0);
    need = 256 - red32(cg);
#pragma unroll
    for (int i = 0; i < 64; ++i) emit(i, ku[i]);
#pragma unroll
    for (int i = 0; i < 64; ++i) emit(64 + i, k2[i]);
  }
}

DI f32x16 mfmaf(float a, float b, f32x16 c) { return __builtin_amdgcn_mfma_f32_32x32x2f32(a, b, c, 0, 0, 0); }

DI void mlstm_stage(const Params& p, int li, int hd, long t0, int cidx, float* QW, float* Kl, float* Vl, bool needq, int tid, int w, int lane) {
  const float* cw = p.conv_w + (long)li * 4 * 512; const float* cb = p.conv_b + li * 512;
  const int d = lane;
#pragma unroll
  for (int which = 0; which < 2; ++which) {
    if (which == 0 && !needq) continue;
    int ch = which * 256 + hd * 64 + d;
    const bf16_t* up = p.U + t0 * NPO + (which ? O_DK : O_DQ) + hd * 64 + d;
    float w0 = cw[ch], w1 = cw[512 + ch], w2 = cw[1024 + ch], w3 = cw[1536 + ch], bias = cb[ch];
    int tl0 = w * 16;
    int s0 = cidx * 64 + tl0;
    float x0 = (s0 - 3 >= 0) ? bf2f(up[(long)(tl0 - 3) * NPO]) : 0.f;
    float x1 = (s0 - 2 >= 0) ? bf2f(up[(long)(tl0 - 2) * NPO]) : 0.f;
    float x2 = (s0 - 1 >= 0) ? bf2f(up[(long)(tl0 - 1) * NPO]) : 0.f;
    float* dstl = which ? Kl : QW;
#pragma unroll 4
    for (int i = 0; i < 16; ++i) {
      float x3 = bf2f(up[(long)(tl0 + i) * NPO]);
      float y = bias + w0 * x0 + w1 * x1 + w2 * x2 + w3 * x3;
      y = siluf(y);
      if (which) y *= 0.125f;
      dstl[(tl0 + i) * 65 + d] = y;
      x0 = x1; x1 = x2; x2 = x3;
    }
  }
#pragma unroll
  for (int i = 0; i < 4; ++i) {
    int cidx2 = tid + 256 * i; int tl = cidx2 >> 4, vc8 = (cidx2 & 15) * 8;
    u32x4 vv = *(const u32x4*)(p.U + (t0 + tl) * NPO + O_DV + hd * 128 + vc8);
    float4 a, bq;
    a.x = bflo(vv.x); a.y = bfhi(vv.x); a.z = bflo(vv.y); a.w = bfhi(vv.y);
    bq.x = bflo(vv.z); bq.y = bfhi(vv.z); bq.z = bflo(vv.w); bq.w = bfhi(vv.w);
    *(float4*)(Vl + tl * 128 + vc8) = a; *(float4*)(Vl + tl * 128 + vc8 + 4) = bq;
  }
}

DI void mlstm_x(const Params& p, int li, int item, char* smem) {
  const int c = item & 63, bh = item >> 6, b = bh >> 2, hd = bh & 3;
  const int tid = tidx(), lane = tid & 63, w = __builtin_amdgcn_readfirstlane(tid >> 6), r = lane & 31, h = lane >> 5;
  float* Kl = (float*)(smem + 16640); float* Vl = (float*)(smem + 33280); float* vws = (float*)(smem + 66048);
  const long t0 = (long)b * S_ + c * 64;
  const float ib = p.i_bias[li * 4 + hd], fb = p.f_bias[li * 4 + hd];
  mlstm_stage(p, li, hd, t0, c, nullptr, Kl, Vl, false, tid, w, lane);
  if (w == 0) {
    float ig = p.misc[(t0 + lane) * 32 + 8 + hd] + ib;
    float fp = p.misc[(t0 + lane) * 32 + 12 + hd] + fb;
    float lf = fminf(fp, 0.f) - log1pf(__expf(-fabsf(fp)));
    float bc = lf;
#pragma unroll
    for (int dlt = 1; dlt < 64; dlt <<= 1) { float t = __shfl_up(bc, dlt); if (lane >= dlt) bc += t; }
    float bL = __shfl(bc, 63);
    float g = bL - bc + ig;
    float gm = g;
#pragma unroll
    for (int dlt = 1; dlt < 64; dlt <<= 1) gm = fmaxf(gm, __shfl_xor(gm, dlt));
    vws[lane] = __expf(g - gm);
    if (lane == 0) { p.mS[(long)item * 4] = bL; p.mS[(long)item * 4 + 1] = gm; }
  }
  __syncthreads();
  f32x16 acc[2] = {zero16(), zero16()};
#pragma unroll
  for (int dt = 0; dt < 2; ++dt)
#pragma unroll 4
    for (int kk = 0; kk < 32; ++kk) {
      int s = 2 * kk + h;
      float a = Kl[s * 65 + dt * 32 + r] * vws[s];
      float bb = Vl[s * 128 + 32 * w + r];
      acc[dt] = mfmaf(a, bb, acc[dt]);
    }
  float* Ug = p.mU + (long)item * 8192 + 32 * w + r;
#pragma unroll
  for (int dt = 0; dt < 2; ++dt)
#pragma unroll
    for (int i = 0; i < 16; ++i) Ug[(dt * 32 + crow(i, h)) * 128] = acc[dt][i];
  if (w == 1) {
    float ns = 0.f;
    for (int s = 0; s < 64; ++s) ns += Kl[s * 65 + lane] * vws[s];
    p.mN[(long)item * 64 + lane] = ns;
  }
}

DI void mlstm_y(const Params& p, int item) {
  const int tid = tidx();
  const long base = (long)item * 64;
  f32x4 C[8], uc[8], un[8];
#pragma unroll
  for (int j = 0; j < 8; ++j) { C[j] = (f32x4){0.f, 0.f, 0.f, 0.f}; un[j] = C[j]; }
  float nn = 0.f, m = 0.f;
  float* Ub = p.mU + base * 8192 + tid * 32;
#pragma unroll
  for (int j = 0; j < 8; ++j) uc[j] = *(const f32x4*)(Ub + 4 * j);
  for (int c = 0; c < 64; ++c) {
    float bL = p.mS[(base + c) * 4], ml = p.mS[(base + c) * 4 + 1];
    float* Uc = Ub + (long)c * 8192;
    if (c + 1 < 64) {
#pragma unroll
      for (int j = 0; j < 8; ++j) un[j] = *(const f32x4*)(Uc + 8192 + 4 * j);
    }
    float mnew = fmaxf(bL + m, ml);
    float decay = __expf(bL + m - mnew), sc = __expf(ml - mnew);
#pragma unroll
    for (int j = 0; j < 8; ++j) { *(f32x4*)(Uc + 4 * j) = C[j]; C[j] = decay * C[j] + sc * uc[j]; uc[j] = un[j]; }
    if (tid == 0) p.mS[(base + c) * 4 + 2] = m;
    if (tid < 64) { float nu = p.mN[(base + c) * 64 + tid]; p.mN[(base + c) * 64 + tid] = nn; nn = decay * nn + sc * nu; }
    m = mnew;
  }
}

DI void mlstm_z(const Params& p, int li, int item, char* smem) {
  const int c = item & 63, bh = item >> 6, b = bh >> 2, hd = bh & 3;
  const int tid = tidx(), lane = tid & 63, w = __builtin_amdgcn_readfirstlane(tid >> 6), r = lane & 31, h = lane >> 5;
  float* QW = (float*)smem;
  float* Kl = (float*)(smem + 16640);
  float* Vl = (float*)(smem + 33280);
  float* vb = (float*)(smem + 66048);
  float* vc = vb + 64; float* vmt = vb + 128; float* va = vb + 192; float* nvec = vb + 320; float* vinv = vb + 384;
  const long t0 = (long)b * S_ + c * 64;
  const float ib = p.i_bias[li * 4 + hd], fb = p.f_bias[li * 4 + hd];
  mlstm_stage(p, li, hd, t0, c, QW, Kl, Vl, true, tid, w, lane);
  if (tid < 64) nvec[tid] = p.mN[(long)item * 64 + tid];
  if (w == 0) {
    const float mstate = p.mS[(long)item * 4 + 2];
    float ig = p.misc[(t0 + lane) * 32 + 8 + hd] + ib;
    float fp = p.misc[(t0 + lane) * 32 + 12 + hd] + fb;
    float lf = fminf(fp, 0.f) - log1pf(__expf(-fabsf(fp)));
    float bc = lf;
#pragma unroll
    for (int dlt = 1; dlt < 64; dlt <<= 1) { float t = __shfl_up(bc, dlt); if (lane >= dlt) bc += t; }
    float cc = ig - bc;
    float pm = cc;
#pragma unroll
    for (int dlt = 1; dlt < 64; dlt <<= 1) { float t = __shfl_up(pm, dlt); if (lane >= dlt) pm = fmaxf(pm, t); }
    float mt = bc + fmaxf(mstate, pm);
    float aa = __expf(bc + mstate - mt);
    vb[lane] = bc; vc[lane] = cc; vmt[lane] = mt; va[lane] = aa;
  }
  __syncthreads();
  float qn = 0.f;
  if (w == 0) { for (int d = 0; d < 64; ++d) qn += QW[lane * 65 + d] * nvec[d]; }
  f32x16 hacc[2] = {zero16(), zero16()};
  {
    const float* Cg = p.mU + (long)item * 8192 + 32 * w + r;
#pragma unroll 8
    for (int kk = 0; kk < 32; ++kk) {
      float bb = Cg[(2 * kk + h) * 128];
      float a0 = QW[r * 65 + 2 * kk + h], a1 = QW[(32 + r) * 65 + 2 * kk + h];
      hacc[0] = mfmaf(a0, bb, hacc[0]);
      hacc[1] = mfmaf(a1, bb, hacc[1]);
    }
  }
  f32x16 sacc = zero16();
  const int tt_s = w >> 1, st_s = w & 1;
#pragma unroll 4
  for (int kk = 0; kk < 32; ++kk) {
    float a = QW[(tt_s * 32 + r) * 65 + 2 * kk + h];
    float bb = Kl[(st_s * 32 + r) * 65 + 2 * kk + h];
    sacc = mfmaf(a, bb, sacc);
  }
  __syncthreads();
  {
    int s = st_s * 32 + r; float cs_ = vc[s];
#pragma unroll
    for (int i = 0; i < 16; ++i) {
      int t = tt_s * 32 + crow(i, h);
      float wv = (s <= t) ? sacc[i] * __expf(vb[t] - vmt[t] + cs_) : 0.f;
      QW[t * 65 + s] = wv;
    }
  }
  __syncthreads();
#pragma unroll
  for (int tt = 0; tt < 2; ++tt)
#pragma unroll
    for (int i = 0; i < 16; ++i) hacc[tt][i] *= va[tt * 32 + crow(i, h)];
#pragma unroll 4
  for (int kk = 0; kk < 32; ++kk) {
    float bb = Vl[(2 * kk + h) * 128 + 32 * w + r];
    float a0 = QW[r * 65 + 2 * kk + h], a1 = QW[(32 + r) * 65 + 2 * kk + h];
    hacc[0] = mfmaf(a0, bb, hacc[0]);
    hacc[1] = mfmaf(a1, bb, hacc[1]);
  }
  if (w == 0) {
    float rsum = 0.f;
    for (int s = 0; s < 64; ++s) rsum += QW[lane * 65 + s];
    float den = va[lane] * qn + rsum;
    float dn = fmaxf(fabsf(den), __expf(-vmt[lane]));
    vinv[lane] = 1.f / dn;
  }
  __syncthreads();
#pragma unroll
  for (int tt = 0; tt < 2; ++tt)
#pragma unroll
    for (int i = 0; i < 16; ++i) { int t = tt * 32 + crow(i, h); Vl[t * 128 + 32 * w + r] = hacc[tt][i] * vinv[t]; }
  __syncthreads();
  {
    int t = tid >> 2, q = tid & 3;
    const float* hr = Vl + t * 128 + q * 32;
    float ss = 0.f;
#pragma unroll
    for (int i = 0; i < 8; ++i) { float4 v = ((const float4*)hr)[i]; ss += v.x * v.x + v.y * v.y + v.z * v.z + v.w * v.w; }
    ss += __shfl_xor(ss, 1); ss += __shfl_xor(ss, 2);
    float rn = rsqrtf(ss * (1.f / 128.f) + EPS);
    const float* gn = p.h_norm_g + li * 128 + q * 32;
    const bf16_t* op = p.U + (t0 + t) * NPO + O_DO + hd * 128 + q * 32;
    const bf16_t* gp = p.U + (t0 + t) * NPO + O_DGATE + hd * 128 + q * 32;
    bf16_t* dst = p.mix + (t0 + t) * 1280 + 512 + hd * 128 + q * 32;
#pragma unroll
    for (int cch = 0; cch < 4; ++cch) {
      u32x4 ov = *(const u32x4*)(op + cch * 8), gv = *(const u32x4*)(gp + cch * 8);
      float y[8];
#pragma unroll
      for (int j = 0; j < 8; ++j) y[j] = hr[cch * 8 + j] * rn * gn[cch * 8 + j];
      y[0] *= sigmf(bflo(ov.x)) * siluf(bflo(gv.x)); y[1] *= sigmf(bfhi(ov.x)) * siluf(bfhi(gv.x));
      y[2] *= sigmf(bflo(ov.y)) * siluf(bflo(gv.y)); y[3] *= sigmf(bfhi(ov.y)) * siluf(bfhi(gv.y));
      y[4] *= sigmf(bflo(ov.z)) * siluf(bflo(gv.z)); y[5] *= sigmf(bfhi(ov.z)) * siluf(bfhi(gv.z));
      y[6] *= sigmf(bflo(ov.w)) * siluf(bflo(gv.w)); y[7] *= sigmf(bfhi(ov.w)) * siluf(bfhi(gv.w));
      u32x4 o; o.x = pk2(y[0], y[1]); o.y = pk2(y[2], y[3]); o.z = pk2(y[4], y[5]); o.w = pk2(y[6], y[7]);
      *(u32x4*)(dst + cch * 8) = o;
    }
  }
}

DI int inproj_count(int layer) { return 256 * (((layer & 1) ? NPO : NPE) / 128) + (layer == 0 ? 256 : 0); }
DI void inproj_task(const Params& p, int layer, int t, char* smem) {
  const bool odd = layer & 1; const int li = layer >> 1;
  const int NP = odd ? NPO : NPE; const int ntn = NP / 128; const int nin = 256 * ntn;
#define ROWF [&](int row, const float* v, float rs)
  if (t < nin) {
    int mt = t / ntn, nt = t % ntn;
    if (!odd) {
      gemm_tile<true>(p.xb, DM, p.WinT[layer], DM, mt * 128, nt * 128, smem, [&](int gi, int c8, auto run) {
        bf16_t* d0 = p.U + gi * 64;
        auto n64 = [&](const float* g, bool rope) {
          if (rope) run(ROWF { ep_norm64(v, c8, rs, g, p.rope64 + (long)row * 64, d0 + (long)row * NPE); });
          else run(ROWF { ep_norm64(v, c8, rs, g, nullptr, d0 + (long)row * NPE); });
        };
        if (gi == 6) {
          if (c8 < 4) run(ROWF { ep_head<16, true>(v, 0, c8, rs, p.mla_k_norm_g + li * 96 + 64, p.rope32 + (long)row * 32, d0 + (long)row * NPE); });
          else run(ROWF { ep_zero(c8, d0 + (long)row * NPE); });
        }
        else if (gi >= 15 && gi < 23) n64(p.nsa_q_g + li * 64, true);
        else if (gi == 27 || gi == 28) n64(p.nsa_k_g + li * 192 + 64, true);
        else if (gi == 31 || gi == 32) n64(p.nsa_k_g + li * 192 + 128, true);
        else if (gi >= 43 && gi < 47) n64(p.mem_q_g + layer * 64, false);
        else if (gi == 51) { if (c8 < 3) run(ROWF { float x[8]; ld8(v + 8 * c8, x);
#pragma unroll
            for (int j = 0; j < 8; ++j) p.misc[(long)row * 32 + 8 * c8 + j] = x[j] * rs; }); }
        else run(ROWF { ep_plain(v, c8, rs, d0 + (long)row * NPE); });
      });
    } else {
      gemm_tile<true>(p.xb, DM, p.WinT[layer], DM, mt * 128, nt * 128, smem, [&](int gi, int c8, auto run) {
        bf16_t* d0 = p.U + gi * 64;
        if (gi <= 8) { const float* g = (gi < 8 ? p.dsa_q_g : p.dsa_k_g) + li * 64;
          run(ROWF { ep_norm64(v, c8, rs, g, p.rope64 + (long)row * 64, d0 + (long)row * NPO); }); }
        else if (gi >= 10 && gi < 14) run(ROWF { ep_head<16, false>(v, (c8 >> 2) * 32, c8 & 3, rs, nullptr, p.rope32 + (long)row * 32, d0 + (long)row * NPO); });
        else if (gi == 14) {
          if (c8 < 4) run(ROWF { ep_head<16, false>(v, 0, c8, rs, nullptr, p.rope32 + (long)row * 32, d0 + (long)row * NPO); });
          else run(ROWF { ep_zero(c8, d0 + (long)row * NPO); });
        }
        else if (gi >= 55 && gi < 59) { const float* g = p.mem_q_g + layer * 64; run(ROWF { ep_norm64(v, c8, rs, g, nullptr, d0 + (long)row * NPO); }); }
        else if (gi == 63) { if (c8 < 2) run(ROWF { float x[8]; ld8(v + 8 * c8, x);
#pragma unroll
            for (int j = 0; j < 8; ++j) p.misc[(long)row * 32 + 8 * c8 + j] = x[j] * rs; }); }
        else run(ROWF { ep_plain(v, c8, rs, d0 + (long)row * NPO); });
      });
    }
  } else {
    int u = t - nin; int l = u >> 6, mt = (u >> 2) & 15, nt = u & 3;
    gemm_tile<true>(p.memb, DM, p.WmemT + (long)l * 512 * 1024, DM, mt * 128, nt * 128, smem, [&](int gi, int c8, auto run) {
      if (gi < 4) run(ROWF { ep_norm64(v, c8, rs, p.mem_k_g + l * 64, nullptr, p.memk + ((long)l * 2048 + row) * 256 + gi * 64); });
      else run(ROWF { ep_plain(v, c8, rs, p.memv + ((long)l * 2048 + row) * 256 + (gi - 4) * 64); });
    });
  }
}
constexpr int NPREP = 2048 + 2048 + 256;
DI void prep_task(const Params& p, int li, int t, char* smem) {
  const int ncmp = 256, nuq = 2048;
  if (t < ncmp) {
    __syncthreads();
    cmp_item(p, li, t, smem);
  } else if (t < ncmp + nuq) {
    int u0 = t - ncmp; int mt = u0 >> 3, hd = u0 & 7;
    gemm_tile<true>(p.U + E_AQL, NPE, p.WuqT + (long)li * 1024 * 256, 256, mt * 128, hd * 128, smem, [&](int gi, int c8, auto run) {
      bf16_t* d0 = p.qbuf + hd * 96;
      if ((gi & 1) == 0) run(ROWF { ep_norm64(v, c8, rs, p.mla_q_norm_g + li * 96, nullptr, d0 + (long)row * 768); });
      else if (c8 < 4) run(ROWF { ep_head<16, true>(v, 0, c8, rs, p.mla_q_norm_g + li * 96 + 64, p.rope32 + (long)row * 32, d0 + (long)row * 768 + 64); });
    });
  } else {
    int u = t - ncmp - nuq; int mt = u >> 3, hd = u & 7;
    gemm_tile<true>(p.U + E_AKVL, NPE, p.WukvT + (long)li * 1024 * 128, 128, mt * 128, hd * 128, smem, [&](int gi, int c8, auto run) {
      if ((gi & 1) == 0) run(ROWF { ep_norm64(v, c8, rs, p.mla_k_norm_g + li * 96, nullptr, p.kbuf + (long)row * 512 + hd * 64); });
      else run(ROWF { ep_plain(v, c8, rs, p.vbuf + (long)row * 512 + hd * 64); });
    });
  }
}
DI void outproj_task(const Params& p, int layer, int t, char* smem) {
  const float* xold = (layer == 0) ? p.x : p.out;
  int mt = t >> 3, nt = t & 7;
  gemm_tile<false>(p.mix, 1280, p.WoutT + (long)layer * 1024 * 1280, 1280, mt * 128, nt * 128, smem, [&](int gi, int c8, auto run) {
    run(ROWF {
      const long o = (long)row * DM + gi * 64 + 8 * c8;
      float x[8]; ld8(v + 8 * c8, x);
      float4 xa = *(const float4*)(xold + o), xb2 = *(const float4*)(xold + o + 4);
      x[0] += xa.x; x[1] += xa.y; x[2] += xa.z; x[3] += xa.w; x[4] += xb2.x; x[5] += xb2.y; x[6] += xb2.z; x[7] += xb2.w;
      { f32x4 y0 = {x[0], x[1], x[2], x[3]}, y1 = {x[4], x[5], x[6], x[7]};
        __builtin_nontemporal_store(y0, (f32x4*)(p.out + o)); __builtin_nontemporal_store(y1, (f32x4*)(p.out + o + 4)); }
      st8bf(p.xb + o, x);
    });
  });
}
#undef ROWF

typedef const __attribute__((address_space(4))) Params* KParams;
DI const Params& kparams() {
  KParams kp = (KParams)__builtin_amdgcn_kernarg_segment_ptr();
  asm volatile("" : "+s"(kp));
  return *(const Params*)kp;
}
DI int snake(int k, int t0, int bid, int nb, int total) { int tr = k * nb + (nb - 1 - bid); return ((k & 1) && (k + 1) * nb <= total) ? tr : t0; }
#define XB_TMO      128
#define XB_XCNT(j)  (256  + 64 * (j))
#define XB_XSUB(j)  (1280 + 64 * (j))
#define XB_XGEN(j)  (2304 + 64 * (j))
#define XB_TOP      3328
#define XB_TOPGEN   3392
#define XCD_BAR_WORDS 3456
#define XB_SPIN_CAP (1u << 22)
#define LAS __attribute__((address_space(3)))
DI unsigned xb_ld(unsigned* p) { return __hip_atomic_load(p, __ATOMIC_RELAXED, __HIP_MEMORY_SCOPE_AGENT); }
DI unsigned xb_add(unsigned* p, unsigned v) { return __hip_atomic_fetch_add(p, v, __ATOMIC_RELAXED, __HIP_MEMORY_SCOPE_AGENT); }
DI unsigned xb_xcc_id() { return (unsigned)__builtin_amdgcn_s_getreg((3 << 11) | 20) & 0xFu; }
#define XB_SPIN(cond, bar) do { unsigned _sp = 0; while (cond) { __builtin_amdgcn_s_sleep(1); \
    if ((++_sp & 255u) == 0u) { if (xb_ld(&(bar)[XB_TMO])) break; if (_sp > XB_SPIN_CAP) { atomicAdd(&(bar)[XB_TMO], 1u); break; } } } } while (0)
struct XcdBarrier { unsigned* bar; unsigned x; volatile LAS unsigned* st; };
DI XcdBarrier xcd_barrier_post(unsigned* bar, volatile LAS unsigned* st) {
  XcdBarrier b; b.bar = bar; b.x = xb_xcc_id(); b.st = st;
  if (threadIdx.x == 0) (void)xb_add(&bar[XB_XCNT(b.x)], 1u);
  return b;
}
DI void xcd_barrier_complete(unsigned* bar, unsigned x, unsigned& nloc, unsigned& nx) {
  const unsigned G = gridDim.x * gridDim.y * gridDim.z;
  unsigned sum, cnt, mine, sp = 0u;
  for (;;) {
    sum = 0u; cnt = 0u; mine = 0u;
#pragma unroll
    for (unsigned j = 0; j < 16; ++j) { const unsigned c = xb_ld(&bar[XB_XCNT(j)]); sum += c; cnt += (c > 0u) ? 1u : 0u; mine = (j == x) ? c : mine; }
    if (sum == G) break;
    __builtin_amdgcn_s_sleep(1);
    if ((++sp & 255u) == 0u) { if (xb_ld(&bar[XB_TMO])) break; if (sp > XB_SPIN_CAP) { atomicAdd(&bar[XB_TMO], 1u); break; } }
  }
  nloc = mine > 0u ? mine : 1u; nx = cnt > 0u ? cnt : 1u;
}
DI void xcd_barrier(const XcdBarrier& b) {
  asm volatile("s_waitcnt vmcnt(0)" ::: "memory");
  __syncthreads();
  if (threadIdx.x == 0) {
    unsigned* bar = b.bar;
    __builtin_amdgcn_s_waitcnt(0);
    unsigned nloc = b.st[0], nx = b.st[1];
    if (nloc == 0u) { xcd_barrier_complete(bar, b.x, nloc, nx); b.st[0] = nloc; b.st[1] = nx; }
    const unsigned old = xb_add(&bar[XB_XSUB(b.x)], 1u);
    const unsigned gen = old / nloc;
    if (old + 1u == (gen + 1u) * nloc) {
      __builtin_amdgcn_fence(__ATOMIC_RELEASE, "agent");
      asm volatile("s_waitcnt vmcnt(0)" ::: "memory");
      const unsigned og = xb_add(&bar[XB_TOP], 1u);
      const unsigned tg = og / nx;
      if (og + 1u == (tg + 1u) * nx) xb_add(&bar[XB_TOPGEN], 1u);
      else XB_SPIN(xb_ld(&bar[XB_TOPGEN]) == tg, bar);
      __builtin_amdgcn_fence(__ATOMIC_ACQUIRE, "agent");
      xb_add(&bar[XB_XGEN(b.x)], 1u);
      asm volatile("s_waitcnt vmcnt(0)" ::: "memory");
    } else {
      XB_SPIN(xb_ld(&bar[XB_XGEN(b.x)]) == gen, bar);
      __builtin_amdgcn_fence(__ATOMIC_ACQUIRE, "agent");
      asm volatile("s_waitcnt vmcnt(0)" ::: "memory");
    }
  }
  __syncthreads();
}
#define SMEM_DECL __shared__ __attribute__((aligned(16))) char smem[SMEM_BYTES]
__global__ void __launch_bounds__(256, 2) mega(Params p_) {
  SMEM_DECL;
  cg::grid_group grid = cg::this_grid();
  const int bid = blockIdx.x, nb = gridDim.x;
  int phase = 0;
#define PSYNC() do { ++phase; XcdBarrier xb_; xb_.bar = kparams().bar; xb_.x = xb_xcc_id(); xb_.st = (volatile LAS unsigned*)(smem + 70400); xcd_barrier(xb_); if (phase >= PHASE_LIMIT) return; } while (0)
  { const Params& p = kparams(); phase0(p, bid * 256 + tidx(), nb * 256);
    if (bid == 0) for (int i = threadIdx.x; i < XCD_BAR_WORDS; i += 256) __hip_atomic_store(p.bar + i, 0u, __ATOMIC_RELAXED, __HIP_MEMORY_SCOPE_AGENT); }
  if (threadIdx.x < 4) ((volatile unsigned*)(smem + 70400))[threadIdx.x] = 0u;
  grid.sync();
  (void)xcd_barrier_post(kparams().bar, (volatile LAS unsigned*)(smem + 70400));
  for (int layer = 0; layer < 4; ++layer) {
    const bool odd = layer & 1; const int li = layer >> 1;
    { const Params& p = kparams();
      const int ntn = (odd ? NPO : NPE) / 128;
      if ((nb & 7) == 0) {
        const int xcd = bid & 7, per = nb >> 3, tot = 32 * ntn;
        for (int j = bid >> 3; j < tot; j += per) {
          int mg = j / (8 * ntn), rem = j - mg * 8 * ntn, nt = rem >> 3, mi = rem & 7;
          inproj_task(p, layer, (xcd * 32 + mg * 8 + mi) * ntn + nt, smem);
        }
      } else {
        for (int t = bid; t < 256 * ntn; t += nb) inproj_task(p, layer, t, smem);
      }
      if (layer == 0) for (int t = bid; t < 256; t += nb) inproj_task(p, layer, 256 * ntn + t, smem);
    }
    PSYNC();
    if (!odd) {
      { const Params& p = kparams(); for (int t = bid; t < NPREP; t += nb) prep_task(p, li, t, smem); }
      PSYNC();
      { const Params& p = kparams(); for (int k = 0, t0 = bid; t0 < 2048 / MLA_NCT; ++k, t0 += nb) { int t = snake(k, t0, bid, nb, 2048 / MLA_NCT); __syncthreads(); mla_item(p, t, smem); } }
      { const Params& p = kparams(); for (int k = 0, t0 = bid; t0 < 2048; ++k, t0 += nb) { int t = snake(k, t0, bid, nb, 2048); __syncthreads(); nsa_item(p, t, smem); } }
      { const Params& p = kparams(); for (int t = bid; t < 1024 / MEM_NCT; t += nb) { __syncthreads(); mem_item(p, layer, t, smem); } }
      PSYNC();
    } else {
      { const Params& p = kparams();
        for (int t = bid; t < 2048 + 4096; t += nb) {
          __syncthreads();
          if (t < 2048) mlstm_x(p, li, t, smem); else dsa_select_item(p, t - 2048, smem);
        } }
      PSYNC();
      if (bid < 32) { const Params& p = kparams(); mlstm_y(p, bid); }
      if (bid >= 32) { const Params& p = kparams(); const int nb2 = nb - 32, b2 = bid - 32;
        for (int k = 0, t0 = b2; t0 < 2048 / DSA_NCT; ++k, t0 += nb2) { int t = snake(k, t0, b2, nb2, 2048 / DSA_NCT); __syncthreads(); dsa_item(p, t, smem); } }
      { const Params& p = kparams(); for (int t = bid; t < 1024 / MEM_NCT; t += nb) { __syncthreads(); mem_item(p, layer, t, smem); } }
      PSYNC();
      { const Params& p = kparams(); for (int t = bid; t < 2048; t += nb) { __syncthreads(); mlstm_z(p, li, t, smem); } }
      PSYNC();
    }
    { const Params& p = kparams();
      if ((nb & 7) == 0) {
        const int xcd = bid & 7, per = nb >> 3;
        for (int j = bid >> 3; j < 256; j += per) {
          int mg = j >> 6, rem = j & 63, nt = rem >> 3, mi = rem & 7;
          outproj_task(p, layer, (xcd * 32 + mg * 8 + mi) * 8 + nt, smem);
        }
      } else {
        for (int t = bid; t < 2048; t += nb) outproj_task(p, layer, t, smem);
      }
    }
    if (layer < 3) PSYNC();
  }
}

extern "C" void kernel_launch(void* const* d_in, const int* in_sizes, int n_in, void* d_out, int out_size, void* d_ws, size_t ws_size,
                              hipStream_t stream) {
  Params p{};
  const float* const* fin = (const float* const*)d_in;
  p.x = fin[0]; p.mem = fin[1]; p.pos = (const int*)d_in[2];
  p.ln_g = fin[3]; p.mem_norm_g = fin[4]; p.mem_w_kv = fin[5]; p.mem_q_g = fin[6]; p.mem_k_g = fin[7]; p.w_out = fin[8];
  p.even_w_in = fin[9]; p.mla_q_lat_g = fin[10]; p.mla_kv_lat_g = fin[11]; p.mla_w_uq = fin[12]; p.mla_w_ukv = fin[13];
  p.mla_q_norm_g = fin[14]; p.mla_k_norm_g = fin[15]; p.nsa_q_g = fin[16]; p.nsa_k_g = fin[17]; p.nsa_cmp_pos = fin[18];
  p.nsa_cmp_w1 = fin[19]; p.nsa_cmp_w2 = fin[20]; p.odd_w_in = fin[21]; p.dsa_q_g = fin[22]; p.dsa_k_g = fin[23];
  p.conv_w = fin[24]; p.conv_b = fin[25]; p.i_bias = fin[26]; p.f_bias = fin[27]; p.h_norm_g = fin[28];
  p.out = (float*)d_out;
  char* ws = (char*)d_ws; size_t off = 0;
  auto take = [&](size_t bytes) { char* r = ws + off; off += (bytes + 255) & ~(size_t)255; return r; };
  const size_t MB = 1u << 20;
  char* U = take(336 * MB);
  p.U = (bf16_t*)U; p.qbuf = (bf16_t*)(U + 208 * MB); p.xb = (bf16_t*)(U + 256 * MB); p.kbuf = (bf16_t*)(U + 256 * MB); p.vbuf = (bf16_t*)(U + 288 * MB);
  p.maskw = (unsigned*)(U + 256 * MB); p.mU = (float*)(U + 272 * MB);
  p.mix = (bf16_t*)take((size_t)T_ * 1280 * 2);
  for (int l = 0; l < 4; ++l) p.WinT[l] = (bf16_t*)take((size_t)((l & 1) ? NPO : NPE) * 1024 * 2);
  p.WoutT = (bf16_t*)take((size_t)4 * 1024 * 1280 * 2);
  p.WuqT = (bf16_t*)take((size_t)2 * 1024 * 256 * 2);
  p.WukvT = (bf16_t*)take((size_t)2 * 1024 * 128 * 2);
  p.WmemT = (bf16_t*)take((size_t)4 * 512 * 1024 * 2);
  p.Wc1T = (bf16_t*)take((size_t)4 * 64 * 2048 * 2);
  p.memb = (bf16_t*)take((size_t)NB * 256 * 1024 * 2);
  p.kcmp = (bf16_t*)take((size_t)NB * 256 * 128 * 2);
  p.vcmp = (bf16_t*)take((size_t)NB * 256 * 128 * 2);
  p.memk = (bf16_t*)take((size_t)4 * 2048 * 256 * 2);
  p.memv = (bf16_t*)take((size_t)4 * 2048 * 256 * 2);
  p.rope64 = (float*)take((size_t)T_ * 64 * 4);
  p.rope32 = (float*)take((size_t)T_ * 32 * 4);
  p.misc = (float*)take((size_t)T_ * 32 * 4);
  p.mN = (float*)take((size_t)2048 * 64 * 4);
  p.mS = (float*)take((size_t)2048 * 4 * 4);
  p.bar = (unsigned*)take(XCD_BAR_WORDS * 4);
  if (off > ws_size) { fprintf(stderr, "workspace too small: need %zu have %zu\n", off, ws_size); return; }
  static int grid_blocks = 0;
  if (!grid_blocks) {
    int dev = 0, cus = 0, per_cu = 0;
    (void)hipGetDevice(&dev);
    (void)hipDeviceGetAttribute(&cus, hipDeviceAttributeMultiprocessorCount, dev);
    (void)hipOccupancyMaxActiveBlocksPerMultiprocessor(&per_cu, mega, 256, 0);
    if (per_cu > 2) per_cu = 2;
    if (per_cu < 1) per_cu = 1;
    grid_blocks = cus * per_cu;
  }
  void* args[] = {&p};
  hipError_t e = hipLaunchCooperativeKernel((void*)mega, dim3(grid_blocks), dim3(256), args, 0, stream);
  if (e != hipSuccess) fprintf(stderr, "cooperative launch failed: %s (grid %d)\n", hipGetErrorString(e), grid_blocks);
}
```
